# Optimizing an MI355X kernel written in HIP

```python
import math
import jax
import jax.numpy as jnp
from jax import lax
import numpy as np


D_MODEL = 1024
BATCH = 8
SEQ = 2048
DEPTH = 1
DEC_BATCH = 128
DEC_SEQ = 1
PAST_LEN = 8192
PAGE_SIZE = 128

N_HEADS = 16
KV_HEADS = 4
HEAD_DIM = D_MODEL // N_HEADS
Q_PER_KV = N_HEADS // KV_HEADS
WINDOW = 128
ATTN_BLOCK = WINDOW
ROPE_THETA = 10000.0
Q_DIM = N_HEADS * HEAD_DIM
KV_DIM = KV_HEADS * HEAD_DIM
SSM_EXPAND = 2
D_INNER = SSM_EXPAND * D_MODEL
SSM_HEAD_DIM = 64
SSM_HEADS = D_INNER // SSM_HEAD_DIM
SSM_GROUPS = 4
HEADS_PER_GROUP = SSM_HEADS // SSM_GROUPS
D_STATE = 128
CONV_W = 4
CONV_DIM = D_INNER + 2 * SSM_GROUPS * D_STATE
SSD_CHUNK = 128
D_FF = 4 * D_MODEL
EPS = 1e-6
IN_SPLITS = (Q_DIM, Q_DIM + KV_DIM, Q_DIM + 2 * KV_DIM, Q_DIM + 2 * KV_DIM + D_INNER,
             Q_DIM + 2 * KV_DIM + D_INNER + CONV_DIM, Q_DIM + 2 * KV_DIM + D_INNER + CONV_DIM + SSM_HEADS)
IN_DIM = Q_DIM + 2 * KV_DIM + D_INNER + CONV_DIM + SSM_HEADS + 2 * D_MODEL

kernel_name = 'hybrid_swa_sink_ssd_decoder_step'


def rms_norm(x, g):
    xf = x.astype(jnp.float32)
    y = xf * lax.rsqrt(jnp.mean(xf * xf, axis=-1, keepdims=True) + EPS)
    return (y * g.astype(jnp.float32)).astype(x.dtype)


def rope(x, pos):
    half = HEAD_DIM // 2
    inv = ROPE_THETA ** (-jnp.arange(half, dtype=jnp.float32) / half)
    ang = pos.astype(jnp.float32)[:, None] * inv[None, :]
    cos = jnp.cos(ang)[None, :, None, :]
    sin = jnp.sin(ang)[None, :, None, :]
    xf = x.astype(jnp.float32)
    x1, x2 = xf[..., :half], xf[..., half:]
    return jnp.concatenate([x1 * cos - x2 * sin, x2 * cos + x1 * sin], axis=-1).astype(x.dtype)


def sink_attention(q, k, v, mask, sinks):
    s = jnp.einsum('...qkgd,...skd->...kgqs', q.astype(jnp.float32), k.astype(jnp.float32)) * (HEAD_DIM ** -0.5)
    s = jnp.where(mask[..., None, None, :, :], s, -jnp.inf)
    sink = jnp.broadcast_to(sinks.astype(jnp.float32).reshape(KV_HEADS, Q_PER_KV, 1, 1), s.shape[:-1] + (1,))
    p = jax.nn.softmax(jnp.concatenate([s, sink], axis=-1), axis=-1)[..., :-1]
    o = jnp.einsum('...kgqs,...skd->...qkgd', p, v.astype(jnp.float32))
    return o.astype(q.dtype)


def window_attention_prompt(q, k, v, sinks):
    b, t = q.shape[:2]
    nb = t // ATTN_BLOCK
    qb = q.reshape(b, nb, ATTN_BLOCK, KV_HEADS, Q_PER_KV, HEAD_DIM)
    pad = jnp.zeros((b, ATTN_BLOCK, KV_HEADS, HEAD_DIM), k.dtype)

    def band(a):
        prev = jnp.concatenate([pad, a], axis=1)[:, :t].reshape(b, nb, ATTN_BLOCK, KV_HEADS, HEAD_DIM)
        cur = a.reshape(b, nb, ATTN_BLOCK, KV_HEADS, HEAD_DIM)
        return jnp.concatenate([prev, cur], axis=2)

    kb, vb = band(k), band(v)
    blk = jnp.arange(nb)[:, None, None]
    qpos = blk * ATTN_BLOCK + jnp.arange(ATTN_BLOCK)[None, :, None]
    kpos = (blk - 1) * ATTN_BLOCK + jnp.arange(2 * ATTN_BLOCK)[None, None, :]
    mask = (kpos <= qpos) & (kpos > qpos - WINDOW) & (kpos >= 0)
    o = sink_attention(qb, kb, vb, mask, sinks)
    return o.reshape(b, t, Q_DIM)


def window_attention_decode(q, k, v, win_k, win_v, pos, sinks):
    b, t = q.shape[:2]
    w = win_k.shape[1]
    kk = jnp.concatenate([win_k, k], axis=1)
    vv = jnp.concatenate([win_v, v], axis=1)
    kpos = jnp.concatenate([pos[:1] - w + jnp.arange(w), pos])
    mask = (kpos[None, :] <= pos[:, None]) & (kpos[None, :] > pos[:, None] - WINDOW)
    qg = q.reshape(b, t, KV_HEADS, Q_PER_KV, HEAD_DIM)
    o = sink_attention(qg, kk, vv, mask, sinks)
    return o.reshape(b, t, Q_DIM), kk[:, -w:], vv[:, -w:]


def causal_conv(xbc, prev, w, bias):
    xp = jnp.concatenate([prev.astype(xbc.dtype), xbc], axis=1)
    y = lax.conv_general_dilated(xp, w[:, None, :].astype(xbc.dtype), window_strides=(1,), padding='VALID',
                                 dimension_numbers=('NWC', 'WIO', 'NWC'), feature_group_count=CONV_DIM)
    return jax.nn.silu(y + bias), xp[:, -(CONV_W - 1):]


def ssd_scan(x, dt, A, Bm, Cm, h0):
    b, T = x.shape[:2]
    L = SSD_CHUNK if T % SSD_CHUNK == 0 else T
    nc = T // L
    G, Hg, P, N = SSM_GROUPS, HEADS_PER_GROUP, SSM_HEAD_DIM, D_STATE
    x = x.reshape(b, nc, L, G, Hg, P)
    dt = dt.reshape(b, nc, L, G, Hg)
    Bm = Bm.reshape(b, nc, L, G, N)
    Cm = Cm.reshape(b, nc, L, G, N)
    cum = jnp.cumsum(dt * A.reshape(G, Hg), axis=2)
    diff = cum[:, :, :, None] - cum[:, :, None, :]
    causal = jnp.tril(jnp.ones((L, L), dtype=bool))[:, :, None, None]
    decay = jnp.exp(jnp.where(causal, diff, -jnp.inf))
    cb = jnp.einsum('bclgn,bcsgn->bclsg', Cm, Bm)
    w_intra = cb[..., None] * decay * dt[:, :, None]
    y = jnp.einsum('bclsgh,bcsghp->bclghp', w_intra, x)
    to_end = jnp.exp(cum[:, :, -1:] - cum) * dt
    st = jnp.einsum('bcsgn,bcsgh,bcsghp->bcghpn', Bm, to_end, x)
    chunk_decay = jnp.exp(cum[:, :, -1])

    def step(h, inp):
        s_c, d_c = inp
        return d_c[..., None, None] * h + s_c, h

    h_fin, h_enter = lax.scan(step, h0.reshape(b, G, Hg, P, N),
                              (jnp.moveaxis(st, 1, 0), jnp.moveaxis(chunk_decay, 1, 0)))
    h_enter = jnp.moveaxis(h_enter, 0, 1)
    y = y + jnp.einsum('bclgn,bclgh,bcghpn->bclghp', Cm, jnp.exp(cum), h_enter)
    return y.reshape(b, T, SSM_HEADS, P), h_fin.reshape(b, SSM_HEADS, P, N)


def hybrid_layer(x, pos, conv_prev, ssm_h0, win_k, win_v, w_buf,
                 norm_mix, w_in, q_norm, k_norm, attn_sinks, conv_w, conv_b, dt_bias, a_log, d_skip,
                 ssm_norm, w_attn_o, w_ssm_o, w_out, norm_mlp, w_up, w_down):
    b, t, _ = x.shape
    h = rms_norm(x, norm_mix)
    q, k, v, z, xbc, dt_raw, gates = jnp.split(h @ w_in, IN_SPLITS, axis=-1)
    q = rope(rms_norm(q.reshape(b, t, N_HEADS, HEAD_DIM), q_norm), pos)
    k = rope(rms_norm(k.reshape(b, t, KV_HEADS, HEAD_DIM), k_norm), pos)
    v = v.reshape(b, t, KV_HEADS, HEAD_DIM)
    if win_k is None:
        o_attn = window_attention_prompt(q, k, v, attn_sinks)
        new_k, new_v = k[:, -w_buf:], v[:, -w_buf:]
    else:
        o_attn, new_k, new_v = window_attention_decode(q, k, v, win_k, win_v, pos, attn_sinks)
    xc, conv_state = causal_conv(xbc, conv_prev, conv_w, conv_b)
    xs, Bm, Cm = jnp.split(xc, [D_INNER, D_INNER + SSM_GROUPS * D_STATE], axis=-1)
    dt = jax.nn.softplus(dt_raw.astype(jnp.float32) + dt_bias.astype(jnp.float32))
    A = -jnp.exp(a_log.astype(jnp.float32))
    xs_h = xs.reshape(b, t, SSM_HEADS, SSM_HEAD_DIM).astype(jnp.float32)
    y, h_fin = ssd_scan(xs_h, dt, A,
                        Bm.reshape(b, t, SSM_GROUPS, D_STATE).astype(jnp.float32),
                        Cm.reshape(b, t, SSM_GROUPS, D_STATE).astype(jnp.float32),
                        ssm_h0.astype(jnp.float32))
    y = (y + d_skip.astype(jnp.float32)[:, None] * xs_h).reshape(b, t, D_INNER)
    o_ssm = rms_norm(y * jax.nn.silu(z.astype(jnp.float32)), ssm_norm).astype(x.dtype)
    g_attn, g_ssm = jnp.split(jax.nn.sigmoid(gates), 2, axis=-1)
    mixed = g_attn * (o_attn @ w_attn_o) + g_ssm * (o_ssm @ w_ssm_o)
    x = x + mixed @ w_out
    u = rms_norm(x, norm_mlp) @ w_up
    x = x + jnp.square(jax.nn.relu(u)) @ w_down
    return x, new_k, new_v, conv_state, h_fin.astype(x.dtype)


def setup_inputs(seed: int = 0) -> dict:
    key = jax.random.key(seed)
    ks = jax.random.split(key, 32)
    w_buf = min(WINDOW, PAST_LEN)

    def nrm(k, shape, scale):
        return jax.random.normal(k, shape, jnp.float32) * scale

    def gain(k, n):
        return 1.0 + nrm(k, (DEPTH, n), 0.02)

    dt0 = jnp.exp(jax.random.uniform(ks[20], (DEPTH, SSM_HEADS)) * (math.log(0.1) - math.log(0.001)) + math.log(0.001))
    return {
        'x_prompt': nrm(ks[0], (BATCH, SEQ, D_MODEL), 1.0),
        'x_sample': nrm(ks[1], (DEC_BATCH, DEC_SEQ, D_MODEL), 1.0),
        'cache_k': nrm(ks[2], (DEPTH, DEC_BATCH, w_buf, KV_HEADS, HEAD_DIM), 1.0),
        'cache_v': nrm(ks[3], (DEPTH, DEC_BATCH, w_buf, KV_HEADS, HEAD_DIM), 1.0),
        'state_conv': nrm(ks[4], (DEPTH, DEC_BATCH, CONV_W - 1, CONV_DIM), 1.0),
        'state_ssm': nrm(ks[5], (DEPTH, DEC_BATCH, SSM_HEADS, SSM_HEAD_DIM, D_STATE), 0.1),
        'norm_mix': gain(ks[6], D_MODEL),
        'w_in': nrm(ks[7], (DEPTH, D_MODEL, IN_DIM), D_MODEL ** -0.5),
        'q_norm': gain(ks[8], HEAD_DIM),
        'k_norm': gain(ks[9], HEAD_DIM),
        'attn_sinks': nrm(ks[10], (DEPTH, N_HEADS), 0.5),
        'conv_w': nrm(ks[11], (DEPTH, CONV_W, CONV_DIM), 0.5),
        'conv_b': nrm(ks[12], (DEPTH, CONV_DIM), 0.02),
        'dt_bias': dt0 + jnp.log(-jnp.expm1(-dt0)),
        'a_log': jnp.log(jax.random.uniform(ks[13], (DEPTH, SSM_HEADS), minval=1.0, maxval=16.0)),
        'd_skip': 1.0 + nrm(ks[14], (DEPTH, SSM_HEADS), 0.02),
        'ssm_norm': gain(ks[15], D_INNER),
        'w_attn_o': nrm(ks[16], (DEPTH, Q_DIM, D_MODEL), Q_DIM ** -0.5),
        'w_ssm_o': nrm(ks[17], (DEPTH, D_INNER, D_MODEL), D_INNER ** -0.5),
        'w_out': nrm(ks[18], (DEPTH, D_MODEL, D_MODEL), D_MODEL ** -0.5),
        'norm_mlp': gain(ks[19], D_MODEL),
        'w_up': nrm(ks[21], (DEPTH, D_MODEL, D_FF), D_MODEL ** -0.5),
        'w_down': nrm(ks[22], (DEPTH, D_FF, D_MODEL), D_FF ** -0.5),
    }


def reference(x_prompt, x_sample, cache_k, cache_v, state_conv, state_ssm, norm_mix, w_in, q_norm, k_norm,
              attn_sinks, conv_w, conv_b, dt_bias, a_log, d_skip, ssm_norm, w_attn_o, w_ssm_o, w_out,
              norm_mlp, w_up, w_down):
    b_p, seq = x_prompt.shape[:2]
    dec_seq = x_sample.shape[1]
    w_buf = cache_k.shape[2]
    pos_p = jnp.arange(seq)
    pos_s = PAST_LEN + jnp.arange(dec_seq)
    yp, ys = x_prompt, x_sample
    kp_l, vp_l, cp_l, hp_l, ks_l, vs_l, cs_l, hs_l = [], [], [], [], [], [], [], []
    for l in range(DEPTH):
        lw = (norm_mix[l], w_in[l], q_norm[l], k_norm[l], attn_sinks[l], conv_w[l], conv_b[l], dt_bias[l],
              a_log[l], d_skip[l], ssm_norm[l], w_attn_o[l], w_ssm_o[l], w_out[l], norm_mlp[l], w_up[l], w_down[l])
        conv0 = jnp.zeros((b_p, CONV_W - 1, CONV_DIM), x_prompt.dtype)
        ssm0 = jnp.zeros((b_p, SSM_HEADS, SSM_HEAD_DIM, D_STATE), x_prompt.dtype)
        yp, kp, vp, cp, hp = hybrid_layer(yp, pos_p, conv0, ssm0, None, None, w_buf, *lw)
        ys, k_s, v_s, c_s, h_s = hybrid_layer(ys, pos_s, state_conv[l], state_ssm[l], cache_k[l], cache_v[l],
                                              w_buf, *lw)
        kp_l.append(kp); vp_l.append(vp); cp_l.append(cp); hp_l.append(hp)
        ks_l.append(k_s); vs_l.append(v_s); cs_l.append(c_s); hs_l.append(h_s)
    return (yp, ys, jnp.stack(kp_l), jnp.stack(vp_l), jnp.stack(cp_l), jnp.stack(hp_l),
            jnp.stack(ks_l), jnp.stack(vs_l), jnp.stack(cs_l), jnp.stack(hs_l))
```

```cpp
#include <hip/hip_runtime.h>
#include <cstdio>
#include <cstdint>
#include <cmath>
namespace pg8 {
#define PG8_LAS __attribute__((address_space(3)))
typedef unsigned short bf16_t;
typedef short bf16x8 __attribute__((ext_vector_type(8)));
typedef float f32x4 __attribute__((ext_vector_type(4)));
typedef unsigned u32x4 __attribute__((ext_vector_type(4)));
constexpr int BM = 256, BK = 64, HALF = 128, HTB = HALF * BK * 2  , STAGE_BYTES = 8 * HTB, NXCD = 8, WGM = 8;

__host__ __device__ __forceinline__ int lds_byte(int r, int c) { const int st = (r >> 4) * 2 + (c >> 5), rr = r & 15, cc = c & 31, ob = rr * 64 + cc * 2; return st * 1024 + (ob ^ (((ob >> 9) & 1) << 5)); }
__host__ __device__ __forceinline__ void stage_rc(int b, int& R, int& C) { const int st = b / 1024, sb = b % 1024, swz = sb ^ (((sb >> 9) & 1) << 5); R = (st >> 1) * 16 + swz / 64; C = (st & 1) * 32 + (swz % 64) / 2; }
__host__ __device__ __forceinline__ int perm32(int rho) { const int n = rho >> 4, i = rho & 15; return 8 * (i >> 2) + 4 * n + (i & 3); }

struct Unit { int pm, pn; };
struct Gemm { const bf16_t* A; const bf16_t* Bt; int M, N, K; };

struct StaticOrder {
    int nM, nN, nwg, G, c;
    __host__ __device__ void init(int M, int N, int G_, int c_) { nM = M / BM; nN = N / BM; nwg = nM * nN; G = G_; c = c_; }
    __host__ __device__ bool next(int i, Unit& u) const {
        const long L = (long)i * G + c; if (L >= nwg) return false;
        int wgid = (int)L; { const int q = nwg / NXCD, r = nwg % NXCD, xcd = wgid % NXCD, off = wgid / NXCD; wgid = (xcd < r ? xcd * (q + 1) : r * (q + 1) + (xcd - r) * q) + off; }
        const int nig = WGM * nN, gid = wgid / nig, fm = gid * WGM, gsz = (nM - fm) < WGM ? (nM - fm) : WGM;
        u.pm = fm + ((wgid % nig) % gsz); u.pn = (wgid % nig) / gsz; return true;
    }
    __device__ __forceinline__ void a_ready(const Unit&) const {}
    __device__ __forceinline__ void done(const Unit&) const {}
};

__device__ __forceinline__ unsigned cvt_pk_bf16(float lo, float hi) { unsigned r; asm volatile("v_cvt_pk_bf16_f32 %0, %1, %2" : "=v"(r) : "v"(lo), "v"(hi)); return r; }
typedef float f32x2 __attribute__((ext_vector_type(2)));
template <class Epi, class Sched, bool ALIGN_EPI = false, bool SP2 = false>
__device__ __forceinline__ void gemm_phase(PG8_LAS unsigned char* lds, const Gemm g, const Sched& S, const Epi& E) {
    const int tid = threadIdx.x, wid = __builtin_amdgcn_readfirstlane(tid >> 6), lane = tid & 63, wr = wid >> 2, wc = wid & 3, fr = lane & 15, fq = lane >> 4;
    const int K = g.K, nt = K / BK;
    unsigned voffA[2], voffB[2];
#pragma unroll
    for (int i = 0; i < 2; ++i) { int R, C; stage_rc(tid * 16 + i * 8192, R, C); const int Rb = Epi::PERM ? ((R & ~31) + perm32(R & 31)) : R;
        voffA[i] = (unsigned)(R * K + C) * 2u; voffB[i] = (unsigned)(Rb * K + C) * 2u; }
    const size_t kstep = (size_t)(BK * 2);
    const size_t hstep = (size_t)HALF * K * 2;
    const size_t tstep = 2 * hstep;
    const unsigned ldsw = (unsigned)wid * 1024u;
    const int aoff = lds_byte(wr * 64 + fr, fq * 8), boff = lds_byte(wc * 32 + fr, fq * 8);
#define PG8_SA(b, h) (((b) * 2 + (h)) * HTB)
#define PG8_SB(b, h) ((4 + (b) * 2 + (h)) * HTB)
#define PG8_STAGE(bufoff, gbase, voff) do { _Pragma("unroll") for (int _i = 0; _i < 2; ++_i) \
        __builtin_amdgcn_global_load_lds((const unsigned*)((const char*)(gbase) + (voff)[_i]), (PG8_LAS unsigned*)(lds + (bufoff) + ldsw + _i * 8192), 16, 0, 0); } while (0)
#define PG8_LDA(dst, b, h) do { _Pragma("unroll") for (int m = 0; m < 4; ++m) _Pragma("unroll") for (int k = 0; k < 2; ++k) dst[m][k] = *(const PG8_LAS bf16x8*)(lds + PG8_SA(b, h) + aoff + m * 2048 + k * 1024); } while (0)
#define PG8_LDB(dst, b, h) do { _Pragma("unroll") for (int n = 0; n < 2; ++n) _Pragma("unroll") for (int k = 0; k < 2; ++k) dst[n][k] = *(const PG8_LAS bf16x8*)(lds + PG8_SB(b, h) + boff + n * 2048 + k * 1024); } while (0)
#define PG8_MMA(ai, bj, At, Bt) do { __builtin_amdgcn_s_setprio(1); _Pragma("unroll") for (int m = 0; m < 4; ++m) _Pragma("unroll") for (int n = 0; n < 2; ++n) _Pragma("unroll") for (int k = 0; k < 2; ++k) \
        acc[ai][bj][m][n] = __builtin_amdgcn_mfma_f32_16x16x32_bf16(Bt[n][k], At[m][k], acc[ai][bj][m][n], 0, 0, 0); __builtin_amdgcn_s_setprio(0); } while (0)
#define PG8_WAIT_V(n) asm volatile("s_waitcnt vmcnt(" #n ")" ::: "memory")
#define PG8_WAIT_L(n) asm volatile("s_waitcnt lgkmcnt(" #n ")" ::: "memory")
#define PG8_BAR __builtin_amdgcn_s_barrier()
#define PG8_SCHED __builtin_amdgcn_sched_barrier(0)
    Unit cur, nxt; int ui = 0;
    if (!S.next(0, cur)) return;
    f32x4 acc[2][2][4][2];
#pragma unroll
    for (int a = 0; a < 2; ++a)
#pragma unroll
        for (int b = 0; b < 2; ++b)
#pragma unroll
            for (int m = 0; m < 4; ++m)
#pragma unroll
                for (int n = 0; n < 2; ++n) acc[a][b][m][n] = (f32x4){0.f, 0.f, 0.f, 0.f};
    bf16x8 At[4][2], B0[2][2], B1[2][2];
    const char* cA = (const char*)g.A + (size_t)cur.pm * tstep; const char* cB = (const char*)g.Bt + (size_t)cur.pn * tstep;
    S.a_ready(cur);
    if constexpr (SP2) {
        PG8_STAGE(PG8_SB(0, 0), cB, voffB); PG8_STAGE(PG8_SB(0, 1), cB + hstep, voffB); PG8_STAGE(PG8_SA(0, 0), cA, voffA); PG8_STAGE(PG8_SA(0, 1), cA + hstep, voffA);
        if (wr == 1) PG8_BAR;
        PG8_WAIT_V(2); PG8_BAR;
        PG8_STAGE(PG8_SB(1, 0), cB + kstep, voffB); PG8_STAGE(PG8_SA(1, 0), cA + kstep, voffA); PG8_STAGE(PG8_SB(1, 1), cB + hstep + kstep, voffB);
        PG8_WAIT_V(6); PG8_BAR;
    } else {
        PG8_STAGE(PG8_SB(0, 0), cB, voffB); PG8_STAGE(PG8_SA(0, 0), cA, voffA); PG8_STAGE(PG8_SB(0, 1), cB + hstep, voffB); PG8_STAGE(PG8_SA(0, 1), cA + hstep, voffA);
        if (wr == 1) PG8_BAR;
        PG8_WAIT_V(4); PG8_BAR;
        PG8_STAGE(PG8_SB(1, 0), cB + kstep, voffB); PG8_STAGE(PG8_SA(1, 0), cA + kstep, voffA); PG8_STAGE(PG8_SB(1, 1), cB + hstep + kstep, voffB);
        PG8_WAIT_V(6); PG8_BAR;
    }
    for (;;) {
        const bool has_next = S.next(ui + 1, nxt);
        const char* nA = has_next ? (const char*)g.A + (size_t)nxt.pm * tstep : cA; const char* nB = has_next ? (const char*)g.Bt + (size_t)nxt.pn * tstep : cB;
        for (int t = 0; t < nt; t += 2) {
            const bool last = (t == nt - 2);
            const char* a1 = cA + (size_t)(t + 1) * kstep;
            const char* a2 = last ? nA : cA + (size_t)(t + 2) * kstep; const char* b2 = last ? nB : cB + (size_t)(t + 2) * kstep;
            const char* a3 = a2 + kstep; const char* b3 = b2 + kstep;
            if (last && has_next) S.a_ready(nxt);
            if constexpr (SP2) {
            PG8_LDB(B0, 0, 0); PG8_LDB(B1, 0, 1); PG8_SCHED; PG8_LDA(At, 0, 0); PG8_STAGE(PG8_SA(1, 1), a1 + hstep, voffA);
            PG8_WAIT_V(8); PG8_WAIT_L(0); PG8_BAR; PG8_MMA(0, 0, At, B0); PG8_MMA(0, 1, At, B1); PG8_BAR; PG8_SCHED;
            PG8_LDA(At, 0, 1); PG8_STAGE(PG8_SB(0, 0), b2, voffB); PG8_STAGE(PG8_SB(0, 1), b2 + hstep, voffB); PG8_STAGE(PG8_SA(0, 0), a2, voffA);
            PG8_WAIT_V(8); PG8_WAIT_L(0); PG8_BAR; PG8_MMA(1, 0, At, B0); PG8_MMA(1, 1, At, B1); PG8_BAR; PG8_SCHED;
            PG8_LDB(B0, 1, 0); PG8_LDB(B1, 1, 1); PG8_SCHED; PG8_LDA(At, 1, 0); PG8_STAGE(PG8_SA(0, 1), a2 + hstep, voffA);
            PG8_WAIT_V(8); PG8_WAIT_L(0); PG8_BAR; PG8_MMA(0, 0, At, B0); PG8_MMA(0, 1, At, B1); PG8_BAR; PG8_SCHED;
            PG8_LDA(At, 1, 1); PG8_STAGE(PG8_SB(1, 0), b3, voffB); PG8_STAGE(PG8_SB(1, 1), b3 + hstep, voffB); PG8_STAGE(PG8_SA(1, 0), a3, voffA);
            PG8_WAIT_V(8); PG8_WAIT_L(0); PG8_BAR; PG8_MMA(1, 0, At, B0); PG8_MMA(1, 1, At, B1); PG8_BAR; PG8_SCHED;
            } else {
            PG8_LDB(B0, 0, 0); PG8_SCHED; PG8_LDA(At, 0, 0); PG8_STAGE(PG8_SA(1, 1), a1 + hstep, voffA);
            PG8_WAIT_L(8); PG8_BAR; PG8_WAIT_L(0); PG8_MMA(0, 0, At, B0); PG8_BAR; PG8_SCHED;
            PG8_LDB(B1, 0, 1); PG8_STAGE(PG8_SB(0, 0), b2, voffB);
            PG8_BAR; PG8_WAIT_L(0); PG8_MMA(0, 1, At, B1); PG8_BAR;
            PG8_LDA(At, 0, 1); PG8_STAGE(PG8_SA(0, 0), a2, voffA);
            PG8_BAR; PG8_WAIT_L(0); PG8_MMA(1, 0, At, B0); PG8_BAR; PG8_SCHED;
            PG8_STAGE(PG8_SB(0, 1), b2 + hstep, voffB);
            PG8_WAIT_V(6); PG8_BAR; PG8_MMA(1, 1, At, B1); PG8_BAR;
            PG8_LDB(B0, 1, 0); PG8_SCHED; PG8_LDA(At, 1, 0); PG8_STAGE(PG8_SA(0, 1), a2 + hstep, voffA);
            PG8_WAIT_L(8); PG8_BAR; PG8_WAIT_L(0); PG8_MMA(0, 0, At, B0); PG8_BAR; PG8_SCHED;
            PG8_LDB(B1, 1, 1); PG8_STAGE(PG8_SB(1, 0), b3, voffB);
            PG8_BAR; PG8_WAIT_L(0); PG8_MMA(0, 1, At, B1); PG8_BAR;
            PG8_LDA(At, 1, 1); PG8_STAGE(PG8_SA(1, 0), a3, voffA);
            PG8_BAR; PG8_WAIT_L(0); PG8_MMA(1, 0, At, B0); PG8_BAR; PG8_SCHED;
            PG8_STAGE(PG8_SB(1, 1), b3 + hstep, voffB);
            PG8_WAIT_V(6); PG8_BAR; PG8_MMA(1, 1, At, B1); PG8_BAR;
            }
        }
        if constexpr (ALIGN_EPI) { if (wr == 0) PG8_BAR; }
        if constexpr (!Epi::AFTER_DRAIN) { E(acc, cur, wr, wc, fr, fq); S.done(cur); }
        if (!has_next) break;
#pragma unroll
        for (int a = 0; a < 2; ++a)
#pragma unroll
            for (int b = 0; b < 2; ++b)
#pragma unroll
                for (int m = 0; m < 4; ++m)
#pragma unroll
                    for (int n = 0; n < 2; ++n) acc[a][b][m][n] = (f32x4){0.f, 0.f, 0.f, 0.f};
        cur = nxt; cA = nA; cB = nB; ++ui;
        if constexpr (ALIGN_EPI) { if (wr == 1) PG8_BAR; }
    }
    PG8_WAIT_V(0);
    if constexpr (!ALIGN_EPI) { if (wr == 0) PG8_BAR; }
    PG8_BAR;
    if constexpr (Epi::AFTER_DRAIN) { E.fused(acc, cur, wr, wc, fr, fq, lds, wid, lane); S.done(cur); }
#undef PG8_SA
#undef PG8_SB
#undef PG8_STAGE
#undef PG8_LDA
#undef PG8_LDB
#undef PG8_MMA
#undef PG8_WAIT_V
#undef PG8_WAIT_L
#undef PG8_BAR
#undef PG8_SCHED
}
}
#define GAS __attribute__((address_space(1)))
#define LAS __attribute__((address_space(3)))
typedef unsigned short bf16;
typedef unsigned v4u __attribute__((ext_vector_type(4)));
typedef float f32x4 __attribute__((ext_vector_type(4)));
typedef short bf16x8 __attribute__((ext_vector_type(8)));
typedef GAS unsigned gu32;
typedef GAS unsigned long long gu64;
#define RLX_AGENT __ATOMIC_RELAXED, __HIP_MEMORY_SCOPE_AGENT
#define LDS_WAIT() asm volatile("s_waitcnt lgkmcnt(0)" ::: "memory")
#define VM_WAIT() asm volatile("s_waitcnt vmcnt(0)" ::: "memory")
__device__ __forceinline__ unsigned long long rt() { return __builtin_amdgcn_s_memrealtime(); }
__device__ __forceinline__ unsigned f2bf(float f) { unsigned u = __builtin_bit_cast(unsigned, f); return (u + 0x7fffu + ((u >> 16) & 1u)) >> 16; }
__device__ __forceinline__ unsigned pk2(float lo, float hi) { return f2bf(lo) | (f2bf(hi) << 16); }

#define XB_TMO      128
#define XB_XCNT(j)  (256  + 64 * (j))
#define XB_XSUB(j)  (1280 + 64 * (j))
#define XB_XGEN(j)  (2304 + 64 * (j))
#define XB_TOP      3328
#define XB_TOPGEN   3392
#define XCD_BAR_WORDS 3456
#define XB_SPIN_CAP (1u << 18)

__device__ __forceinline__ unsigned xb_ld(unsigned* p)              { return __hip_atomic_load(p, __ATOMIC_RELAXED, __HIP_MEMORY_SCOPE_AGENT); }
__device__ __forceinline__ unsigned xb_add(unsigned* p, unsigned v) { return __hip_atomic_fetch_add(p, v, __ATOMIC_RELAXED, __HIP_MEMORY_SCOPE_AGENT); }
__device__ __forceinline__ unsigned xb_xcc_id() { return (unsigned)__builtin_amdgcn_s_getreg((3 << 11) | 20) & 0xFu; }
#define XB_SPIN(cond, bar) do { unsigned _sp = 0; while (cond) { __builtin_amdgcn_s_sleep(1); \
    if ((++_sp & 255u) == 0u) { if (xb_ld(&(bar)[XB_TMO])) break; if (_sp > XB_SPIN_CAP) { atomicAdd(&(bar)[XB_TMO], 1u); break; } } } } while (0)

struct XcdBarrier {
    unsigned* bar; unsigned x;
    volatile LAS unsigned* st;
};

__device__ __forceinline__ XcdBarrier xcd_barrier_post(unsigned* bar, volatile LAS unsigned* st) {
    XcdBarrier b; b.bar = bar; b.x = xb_xcc_id(); b.st = st;
    if (threadIdx.x == 0) (void)xb_add(&bar[XB_XCNT(b.x)], 1u);
    return b;
}
__device__ __forceinline__ void xcd_barrier_complete(unsigned* bar, unsigned x, unsigned& nloc, unsigned& nx) {
    const unsigned G = gridDim.x * gridDim.y * gridDim.z;
    unsigned sum, cnt, mine, sp = 0u;
    for (;;) {
        sum = 0u; cnt = 0u; mine = 0u;
#pragma unroll
        for (unsigned j = 0; j < 16; ++j) { const unsigned c = xb_ld(&bar[XB_XCNT(j)]); sum += c; cnt += (c > 0u) ? 1u : 0u; mine = (j == x) ? c : mine; }
        if (sum == G) break;
        __builtin_amdgcn_s_sleep(1);
        if ((++sp & 255u) == 0u) { if (xb_ld(&bar[XB_TMO])) break; if (sp > XB_SPIN_CAP) { atomicAdd(&bar[XB_TMO], 1u); break; } }
    }
    nloc = mine > 0u ? mine : 1u; nx = cnt > 0u ? cnt : 1u;
}

__device__ __forceinline__ void xcd_barrier(const XcdBarrier& b) {
    asm volatile("s_waitcnt vmcnt(0)" ::: "memory");
    __syncthreads();
    if (threadIdx.x == 0) {
        unsigned* bar = b.bar;
        __builtin_amdgcn_s_waitcnt(0);
        unsigned nloc = b.st[0], nx = b.st[1];
        if (nloc == 0u) { xcd_barrier_complete(bar, b.x, nloc, nx); b.st[0] = nloc; b.st[1] = nx; }
        const unsigned old = xb_add(&bar[XB_XSUB(b.x)], 1u);
        const unsigned gen = old / nloc;
        if (old + 1u == (gen + 1u) * nloc) {
            __builtin_amdgcn_fence(__ATOMIC_RELEASE, "agent");
            asm volatile("s_waitcnt vmcnt(0)" ::: "memory");
            const unsigned og = xb_add(&bar[XB_TOP], 1u);
            const unsigned tg = og / nx;
            if (og + 1u == (tg + 1u) * nx) xb_add(&bar[XB_TOPGEN], 1u);
            else XB_SPIN(xb_ld(&bar[XB_TOPGEN]) == tg, bar);
            __builtin_amdgcn_fence(__ATOMIC_ACQUIRE, "agent");
            xb_add(&bar[XB_XGEN(b.x)], 1u);
            asm volatile("s_waitcnt vmcnt(0)" ::: "memory");
        } else {
            XB_SPIN(xb_ld(&bar[XB_XGEN(b.x)]) == gen, bar);
            __builtin_amdgcn_fence(__ATOMIC_ACQUIRE, "agent");
            asm volatile("s_waitcnt vmcnt(0)" ::: "memory");
        }
    }
    __syncthreads();
}

constexpr int NWAVES = 8;
constexpr int DM = 1024, NB = 8, SEQ = 2048, MP = NB * SEQ, DEC = 128, MTOK = MP + DEC, MPAD = 16640;
constexpr int NH = 16, KVH = 4, HD = 64, WIN = 128;
constexpr int DI = 2048, SH = 32, SP = 64, SG = 4, SN = 128, CONVD = 3072, FF = 4096;
constexpr int N1 = 8960;
constexpr float EPS = 1e-6f;
constexpr size_t O_YP = 0, O_YS = 16777216, O_KP = 16908288, O_VP = 17170432, O_CP = 17432576, O_HP = 17506304, O_KS = 19603456, O_VS = 23797760, O_CS = 27992064, O_HS = 29171712;

constexpr size_t MiB = 1u << 20;
constexpr size_t WS_CTL = 0, CTL_ZERO_BYTES = 1 * MiB;
constexpr size_t WS_WT1 = 1 * MiB;
constexpr size_t WS_WTA = 19 * MiB;
constexpr size_t WS_WTS = 21 * MiB;
constexpr size_t WS_WTO = 25 * MiB;
constexpr size_t WS_WTU = 27 * MiB;
constexpr size_t WS_WTD = 35 * MiB;
constexpr size_t WS_ROPE = 43 * MiB;
constexpr size_t WS_DT = 44 * MiB;
constexpr size_t WS_SSQ2 = 47 * MiB;
constexpr size_t WS_SSQ3 = 52 * MiB;
constexpr size_t WS_XB = 54 * MiB;
constexpr size_t WS_Q = 87 * MiB;
constexpr size_t WS_K = 120 * MiB;
constexpr size_t WS_V = 129 * MiB;
constexpr size_t WS_OA = 138 * MiB;
constexpr size_t WS_YZ = 171 * MiB;
constexpr size_t WS_GT = 236 * MiB;
constexpr size_t WS_ZS = 301 * MiB;
constexpr size_t WS_XBC = 366 * MiB;
constexpr size_t WS_END = 464 * MiB;
static_assert(WS_XB + (size_t)MPAD * 1024 * 2 <= WS_Q && WS_Q + (size_t)MPAD * 1024 * 2 <= WS_K && WS_K + (size_t)MPAD * 256 * 2 <= WS_V && WS_V + (size_t)MPAD * 256 * 2 <= WS_OA, "ws map 1");
static_assert(WS_OA + (size_t)MPAD * 1024 * 2 <= WS_YZ && WS_YZ + (size_t)MPAD * 2048 * 2 <= WS_GT && WS_GT + (size_t)MPAD * 2048 * 2 <= WS_ZS && WS_ZS + (size_t)MPAD * 2048 * 2 <= WS_XBC && WS_XBC + (size_t)MPAD * 3072 * 2 <= WS_END, "ws map 2");
static_assert(WS_ZS + (size_t)MPAD * 4096 * 2 <= WS_END && WS_WT1 + (size_t)N1 * 1024 * 2 <= WS_WTA && WS_DT + (size_t)MPAD * 32 * 4 <= WS_SSQ2 && WS_SSQ2 + (size_t)MPAD * 64 * 4 <= WS_SSQ3 && WS_SSQ3 + (size_t)MPAD * 16 * 4 <= WS_XB, "ws map 3");
constexpr int CW_TMO = 0, CW_BAR = 4096;

constexpr int RING_OFF = 0, RING_BYTES = 131072;
constexpr int LDSCTL_OFF = RING_BYTES, MISC_OFF = LDSCTL_OFF + 320;
constexpr int LDS_BYTES = 147456;

__device__ __forceinline__ float bf2f(unsigned short b) { return __uint_as_float((unsigned)b << 16); }
__device__ __forceinline__ float bflo(unsigned w) { return __uint_as_float(w << 16); }
__device__ __forceinline__ float bfhi(unsigned w) { return __uint_as_float(w & 0xffff0000u); }
__device__ __forceinline__ float sigmoidf_(float v) { return 1.0f / (1.0f + __expf(-v)); }
__device__ __forceinline__ float siluf_(float v) { return v / (1.0f + __expf(-v)); }

using pg8::Unit; using pg8::cvt_pk_bf16; using pg8::bf16_t;
typedef unsigned u32x4 __attribute__((ext_vector_type(4)));

struct EpiIn {
    static constexpr bool PERM = true, AFTER_DRAIN = false;
    bf16_t *Q, *Kb, *Vb, *ZS, *XBC, *GT; float* DT; float* out; const float* rope; const float *qn, *kn, *dtb;
    __device__ __forceinline__ void operator()(const f32x4 (&acc)[2][2][4][2], const Unit& u, int wr, int wc, int fr, int fq) const {
        const int pn = u.pn;
        if (pn <= 4) {
            const bool isq = pn < 4;
            const float* gw = isq ? qn : kn;
            f32x4 g[2][2];
#pragma unroll
            for (int bj = 0; bj < 2; ++bj)
#pragma unroll
                for (int n = 0; n < 2; ++n) g[bj][n] = *(const f32x4*)(gw + 32 * bj + 8 * fq + 4 * n);
            const float osc = isq ? 0.125f : 1.0f;
#pragma unroll
            for (int ai = 0; ai < 2; ++ai) {
                if (u.pm == 64 && ai == 1) continue;
#pragma unroll
                for (int m = 0; m < 4; ++m) {
                    const int r = u.pm * 256 + ai * 128 + wr * 64 + m * 16 + fr;
                    float ss = 0.f;
#pragma unroll
                    for (int bj = 0; bj < 2; ++bj)
#pragma unroll
                        for (int n = 0; n < 2; ++n) { const f32x4 v = acc[ai][bj][m][n]; ss += (v[0] * v[0] + v[1] * v[1]) + (v[2] * v[2] + v[3] * v[3]); }
                    ss += __shfl_xor(ss, 16); ss += __shfl_xor(ss, 32);
                    const float rs = 1.0f / sqrtf(ss * (1.0f / 64.0f) + EPS);
                    const int tpos = r < MP ? (r & (SEQ - 1)) : SEQ;
                    const float* rp = rope + (size_t)tpos * 64 + 8 * fq;
                    f32x4 o1[2], o2[2];
#pragma unroll
                    for (int n = 0; n < 2; ++n) {
                        const f32x4 c = *(const f32x4*)(rp + 4 * n), s = *(const f32x4*)(rp + 32 + 4 * n);
                        const f32x4 x1 = acc[ai][0][m][n] * rs * g[0][n], x2 = acc[ai][1][m][n] * rs * g[1][n];
                        o1[n] = (x1 * c - x2 * s) * osc; o2[n] = (x2 * c + x1 * s) * osc;
                    }
                    u32x4 w1, w2;
                    w1.x = cvt_pk_bf16(o1[0][0], o1[0][1]); w1.y = cvt_pk_bf16(o1[0][2], o1[0][3]); w1.z = cvt_pk_bf16(o1[1][0], o1[1][1]); w1.w = cvt_pk_bf16(o1[1][2], o1[1][3]);
                    w2.x = cvt_pk_bf16(o2[0][0], o2[0][1]); w2.y = cvt_pk_bf16(o2[0][2], o2[0][3]); w2.z = cvt_pk_bf16(o2[1][0], o2[1][1]); w2.w = cvt_pk_bf16(o2[1][2], o2[1][3]);
                    if (isq) {
                        bf16_t* dst = Q + (size_t)r * 1024 + (pn * 4 + wc) * 64 + 8 * fq;
                        *(u32x4*)dst = w1; *(u32x4*)(dst + 32) = w2;
                    } else {
                        bf16_t* dst = Kb + (size_t)r * 256 + wc * 64 + 8 * fq;
                        *(u32x4*)dst = w1; *(u32x4*)(dst + 32) = w2;
                        float* fo = nullptr;
                        if (r >= MP) fo = out + O_KS + ((size_t)(r - MP) * 128 + 127) * 256;
                        else if ((r & (SEQ - 1)) >= SEQ - WIN) fo = out + O_KP + ((size_t)(r >> 11) * 128 + ((r & (SEQ - 1)) - (SEQ - WIN))) * 256;
                        if (fo) { fo += wc * 64 + 8 * fq; *(f32x4*)fo = o1[0]; *(f32x4*)(fo + 4) = o1[1]; *(f32x4*)(fo + 32) = o2[0]; *(f32x4*)(fo + 36) = o2[1]; }
                    }
                }
            }
        } else if (pn == 34) {
            if (wc == 0) {
                f32x4 b0 = *(const f32x4*)(dtb + 8 * fq), b1 = *(const f32x4*)(dtb + 8 * fq + 4);
#pragma unroll
                for (int ai = 0; ai < 2; ++ai) {
                    if (u.pm == 64 && ai == 1) continue;
#pragma unroll
                    for (int m = 0; m < 4; ++m) {
                        const int r = u.pm * 256 + ai * 128 + wr * 64 + m * 16 + fr;
                        f32x4 v0 = acc[ai][0][m][0] + b0, v1 = acc[ai][0][m][1] + b1;
#pragma unroll
                        for (int e = 0; e < 4; ++e) { v0[e] = fmaxf(v0[e], 0.f) + log1pf(__expf(-fabsf(v0[e]))); v1[e] = fmaxf(v1[e], 0.f) + log1pf(__expf(-fabsf(v1[e]))); }
                        float* d = DT + (size_t)r * 32 + 8 * fq; *(f32x4*)d = v0; *(f32x4*)(d + 4) = v1;
                    }
                }
            }
        } else {
            const int kind = pn == 5 ? 0 : (pn < 14 ? 1 : (pn < 26 ? 2 : 3));
            bf16_t* base; int ld, c0;
            if (kind == 0) { base = Vb; ld = 256; c0 = 0; } else if (kind == 1) { base = ZS; ld = 2048; c0 = (pn - 6) * 256; } else if (kind == 2) { base = XBC; ld = 3072; c0 = (pn - 14) * 256; } else { base = GT; ld = 2048; c0 = (pn - 26) * 256; }
            c0 += wc * 32 + 8 * fq;
#pragma unroll
            for (int ai = 0; ai < 2; ++ai) {
                if (u.pm == 64 && ai == 1) continue;
#pragma unroll
                for (int m = 0; m < 4; ++m) {
                    const int r = u.pm * 256 + ai * 128 + wr * 64 + m * 16 + fr;
                    float* fo = nullptr;
                    if (kind == 0) {
                        if (r >= MP) fo = out + O_VS + ((size_t)(r - MP) * 128 + 127) * 256;
                        else if ((r & (SEQ - 1)) >= SEQ - WIN) fo = out + O_VP + ((size_t)(r >> 11) * 128 + ((r & (SEQ - 1)) - (SEQ - WIN))) * 256;
                    } else if (kind == 2) {
                        if (r >= MP) fo = out + O_CS + ((size_t)(r - MP) * 3 + 2) * 3072;
                        else if ((r & (SEQ - 1)) >= SEQ - 3) fo = out + O_CP + ((size_t)(r >> 11) * 3 + ((r & (SEQ - 1)) - (SEQ - 3))) * 3072;
                    }
#pragma unroll
                    for (int bj = 0; bj < 2; ++bj) {
                        f32x4 v0 = acc[ai][bj][m][0], v1 = acc[ai][bj][m][1];
                        if (fo) { float* f = fo + c0 + 128 * bj; *(f32x4*)f = v0; *(f32x4*)(f + 4) = v1; }
                        if (kind == 1) {
#pragma unroll
                            for (int e = 0; e < 4; ++e) { v0[e] = siluf_(v0[e]); v1[e] = siluf_(v1[e]); }
                        } else if (kind == 3) {
#pragma unroll
                            for (int e = 0; e < 4; ++e) { v0[e] = sigmoidf_(v0[e]); v1[e] = sigmoidf_(v1[e]); }
                        }
                        u32x4 w; w.x = cvt_pk_bf16(v0[0], v0[1]); w.y = cvt_pk_bf16(v0[2], v0[3]); w.z = cvt_pk_bf16(v1[0], v1[1]); w.w = cvt_pk_bf16(v1[2], v1[3]);
                        *(u32x4*)(base + (size_t)r * ld + c0 + 128 * bj) = w;
                    }
                }
            }
        }
    }
};

struct EpiT1 {
    static constexpr bool PERM = true, AFTER_DRAIN = false;
    const bf16_t* GT; float* T1;
    __device__ __forceinline__ void operator()(const f32x4 (&acc)[2][2][4][2], const Unit& u, int wr, int wc, int fr, int fq) const {
#pragma unroll
        for (int ai = 0; ai < 2; ++ai)
#pragma unroll
            for (int m = 0; m < 4; ++m) {
                const int r = u.pm * 256 + ai * 128 + wr * 64 + m * 16 + fr;
#pragma unroll
                for (int bj = 0; bj < 2; ++bj) {
                    const int c = u.pn * 256 + 128 * bj + wc * 32 + 8 * fq;
                    const u32x4 gw = *(const u32x4*)(GT + (size_t)r * 2048 + c);
                    f32x4 v0 = acc[ai][bj][m][0], v1 = acc[ai][bj][m][1];
                    v0[0] *= bflo(gw.x); v0[1] *= bfhi(gw.x); v0[2] *= bflo(gw.y); v0[3] *= bfhi(gw.y);
                    v1[0] *= bflo(gw.z); v1[1] *= bfhi(gw.z); v1[2] *= bflo(gw.w); v1[3] *= bfhi(gw.w);
                    float* d = T1 + (size_t)r * 1024 + c; *(f32x4*)d = v0; *(f32x4*)(d + 4) = v1;
                }
            }
    }
};
struct EpiMix {
    static constexpr bool PERM = true, AFTER_DRAIN = false;
    const bf16_t* GT; const float* T1; const float* SSQ2; bf16_t* MIX;
    __device__ __forceinline__ void operator()(const f32x4 (&acc)[2][2][4][2], const Unit& u, int wr, int wc, int fr, int fq) const {
#pragma unroll
        for (int ai = 0; ai < 2; ++ai)
#pragma unroll
            for (int m = 0; m < 4; ++m) {
                const int r = u.pm * 256 + ai * 128 + wr * 64 + m * 16 + fr;
                float ss = 0.f;
#pragma unroll
                for (int j = 0; j < 4; ++j) { const f32x4 p = *(const f32x4*)(SSQ2 + (size_t)r * 64 + 16 * fq + 4 * j); ss += (p[0] + p[1]) + (p[2] + p[3]); }
                ss += __shfl_xor(ss, 16); ss += __shfl_xor(ss, 32);
                const float r2 = 1.0f / sqrtf(ss * (1.0f / 2048.0f) + EPS);
#pragma unroll
                for (int bj = 0; bj < 2; ++bj) {
                    const int c = u.pn * 256 + 128 * bj + wc * 32 + 8 * fq;
                    const u32x4 gw = *(const u32x4*)(GT + (size_t)r * 2048 + 1024 + c);
                    const float* tp = T1 + (size_t)r * 1024 + c; const f32x4 t0 = *(const f32x4*)tp, t1 = *(const f32x4*)(tp + 4);
                    f32x4 v0 = acc[ai][bj][m][0] * r2, v1 = acc[ai][bj][m][1] * r2;
                    v0[0] = t0[0] + v0[0] * bflo(gw.x); v0[1] = t0[1] + v0[1] * bfhi(gw.x); v0[2] = t0[2] + v0[2] * bflo(gw.y); v0[3] = t0[3] + v0[3] * bfhi(gw.y);
                    v1[0] = t1[0] + v1[0] * bflo(gw.z); v1[1] = t1[1] + v1[1] * bfhi(gw.z); v1[2] = t1[2] + v1[2] * bflo(gw.w); v1[3] = t1[3] + v1[3] * bfhi(gw.w);
                    u32x4 w; w.x = cvt_pk_bf16(v0[0], v0[1]); w.y = cvt_pk_bf16(v0[2], v0[3]); w.z = cvt_pk_bf16(v1[0], v1[1]); w.w = cvt_pk_bf16(v1[2], v1[3]);
                    *(u32x4*)(MIX + (size_t)r * 1024 + c) = w;
                }
            }
    }
};
struct EpiRes1 {
    static constexpr bool PERM = true, AFTER_DRAIN = false;
    const float* xp; const float* xs; float* out; bf16_t* X1B; float* SSQ3;
    __device__ __forceinline__ void operator()(const f32x4 (&acc)[2][2][4][2], const Unit& u, int wr, int wc, int fr, int fq) const {
#pragma unroll
        for (int ai = 0; ai < 2; ++ai) {
            if (u.pm == 64 && ai == 1) continue;
#pragma unroll
            for (int m = 0; m < 4; ++m) {
                const int r = u.pm * 256 + ai * 128 + wr * 64 + m * 16 + fr;
                const float* xr = r < MP ? xp + (size_t)r * 1024 : xs + (size_t)(r - MP) * 1024;
                float ss = 0.f;
#pragma unroll
                for (int bj = 0; bj < 2; ++bj) {
                    const int c = u.pn * 256 + 128 * bj + wc * 32 + 8 * fq;
                    const f32x4 v0 = acc[ai][bj][m][0] + *(const f32x4*)(xr + c), v1 = acc[ai][bj][m][1] + *(const f32x4*)(xr + c + 4);
                    float* d = out + (size_t)r * 1024 + c; *(f32x4*)d = v0; *(f32x4*)(d + 4) = v1;
                    ss += (v0[0] * v0[0] + v0[1] * v0[1]) + (v0[2] * v0[2] + v0[3] * v0[3]) + (v1[0] * v1[0] + v1[1] * v1[1]) + (v1[2] * v1[2] + v1[3] * v1[3]);
                    u32x4 w; w.x = cvt_pk_bf16(v0[0], v0[1]); w.y = cvt_pk_bf16(v0[2], v0[3]); w.z = cvt_pk_bf16(v1[0], v1[1]); w.w = cvt_pk_bf16(v1[2], v1[3]);
                    *(u32x4*)(X1B + (size_t)r * 1024 + c) = w;
                }
                ss += __shfl_xor(ss, 16); ss += __shfl_xor(ss, 32);
                if (fq == 0) SSQ3[(size_t)r * 16 + u.pn * 4 + wc] = ss;
            }
        }
    }
};
struct EpiUp {
    static constexpr bool PERM = true, AFTER_DRAIN = false;
    const float* SSQ3; bf16_t* ACT;
    __device__ __forceinline__ void operator()(const f32x4 (&acc)[2][2][4][2], const Unit& u, int wr, int wc, int fr, int fq) const {
#pragma unroll
        for (int ai = 0; ai < 2; ++ai)
#pragma unroll
            for (int m = 0; m < 4; ++m) {
                const int r = u.pm * 256 + ai * 128 + wr * 64 + m * 16 + fr;
                const f32x4 p = *(const f32x4*)(SSQ3 + (size_t)r * 16 + 4 * fq);
                float ss = (p[0] + p[1]) + (p[2] + p[3]);
                ss += __shfl_xor(ss, 16); ss += __shfl_xor(ss, 32);
                const float r3 = 1.0f / sqrtf(ss * (1.0f / 1024.0f) + EPS);
#pragma unroll
                for (int bj = 0; bj < 2; ++bj) {
                    const int c = u.pn * 256 + 128 * bj + wc * 32 + 8 * fq;
                    f32x4 v0 = acc[ai][bj][m][0] * r3, v1 = acc[ai][bj][m][1] * r3;
#pragma unroll
                    for (int e = 0; e < 4; ++e) { v0[e] = fmaxf(v0[e], 0.f); v0[e] *= v0[e]; v1[e] = fmaxf(v1[e], 0.f); v1[e] *= v1[e]; }
                    u32x4 w; w.x = cvt_pk_bf16(v0[0], v0[1]); w.y = cvt_pk_bf16(v0[2], v0[3]); w.z = cvt_pk_bf16(v1[0], v1[1]); w.w = cvt_pk_bf16(v1[2], v1[3]);
                    *(u32x4*)(ACT + (size_t)r * 4096 + c) = w;
                }
            }
    }
};
struct EpiDown {
    static constexpr bool PERM = false, AFTER_DRAIN = false;
    float* out;
    __device__ __forceinline__ void operator()(const f32x4 (&acc)[2][2][4][2], const Unit& u, int wr, int wc, int fr, int fq) const {
#pragma unroll
        for (int ai = 0; ai < 2; ++ai) {
            if (u.pm == 64 && ai == 1) continue;
#pragma unroll
            for (int m = 0; m < 4; ++m) {
                const int r = u.pm * 256 + ai * 128 + wr * 64 + m * 16 + fr;
#pragma unroll
                for (int bj = 0; bj < 2; ++bj)
#pragma unroll
                    for (int n = 0; n < 2; ++n) {
                        float* d = out + (size_t)r * 1024 + u.pn * 256 + 128 * bj + wc * 32 + 16 * n + 4 * fq;
                        *(f32x4*)d = *(const f32x4*)d + acc[ai][bj][m][n];
                    }
            }
        }
    }
};

struct Args { const float* in[23]; float* out; unsigned char* ws; double invf[32]; int ph_lo, ph_hi; };
enum { I_XP = 0, I_XS, I_CK, I_CV, I_SC, I_SS, I_NMIX, I_WIN, I_QN, I_KN, I_SINK, I_CW, I_CB, I_DTB, I_ALOG, I_DSK, I_SNORM, I_WAO, I_WSO, I_WOUT, I_NMLP, I_WUP, I_WDN };

struct Frame {
    LAS unsigned char* lds;
    int tid, lane, wave, vcu, G;
};

__device__ __forceinline__ float wave_sum(float v) {
#pragma unroll
    for (int o = 1; o < 64; o <<= 1) v += __shfl_xor(v, o);
    return v;
}
__device__ __forceinline__ float wave_max(float v) {
#pragma unroll
    for (int o = 1; o < 64; o <<= 1) v = fmaxf(v, __shfl_xor(v, o));
    return v;
}

__device__ __forceinline__ void p0_transpose_item(const float* W, int K, int N, bf16* WT, int prow0, const float* gain, LAS float* scr, int k0, int n0, int lane) {
#pragma unroll 8
    for (int i = 0; i < 32; ++i) { const int kk = 2 * i + (lane >> 5); float v = W[(size_t)(k0 + kk) * N + n0 + (lane & 31)]; if (gain) v *= gain[k0 + kk]; scr[kk * 33 + (lane & 31)] = v; }
    LDS_WAIT(); asm volatile("" ::: "memory");
    const int c = lane & 7;
#pragma unroll
    for (int j = 0; j < 4; ++j) { const int n = (lane >> 3) + 8 * j; const LAS float* s = scr + (8 * c) * 33 + n;
        v4u o; o.x = pk2(s[0 * 33], s[1 * 33]); o.y = pk2(s[2 * 33], s[3 * 33]); o.z = pk2(s[4 * 33], s[5 * 33]); o.w = pk2(s[6 * 33], s[7 * 33]);
        *(GAS v4u*)(WT + (size_t)(prow0 + n) * K + k0 + 8 * c) = o; }
    LDS_WAIT(); asm volatile("" ::: "memory");
}
__device__ __forceinline__ int win_phys_row(int n0) {
    if (n0 < 1280) { const int tile = n0 >> 8, within = n0 & 255, hh = within >> 6, half = (within & 63) >> 5; return tile * 256 + 128 * half + 32 * hh; }
    if (n0 < 6656) return n0;
    if (n0 < 6688) return 8704 + (n0 - 6656);
    return n0 - 32;
}

__device__ __forceinline__ void p0_prologue(Frame& F, const Args& a) {
    unsigned char* ws = a.ws;
    LAS float* scr = (LAS float*)(F.lds + RING_OFF + F.wave * 16384);
    const int gw = F.vcu * NWAVES + F.wave, NGW = F.G * NWAVES;
    constexpr int I_1 = 16 * 273, I_A = 16 * 32, I_S = 32 * 32, I_O = 16 * 32, I_U = 16 * 128, I_D = 64 * 32;
    constexpr int NITEMS = I_1 + I_A + I_S + I_O + I_U + I_D;
    for (int it = gw; it < NITEMS; it += NGW) {
        int r = it;
        if (r < I_1) { const int kb = r / 273, nb = r % 273; p0_transpose_item(a.in[I_WIN], 1024, 8736, (bf16*)(ws + WS_WT1), win_phys_row(nb * 32), a.in[I_NMIX], scr, kb * 64, nb * 32, F.lane); continue; } r -= I_1;
        if (r < I_A) { const int kb = r / 32, nb = r % 32; p0_transpose_item(a.in[I_WAO], 1024, 1024, (bf16*)(ws + WS_WTA), nb * 32, nullptr, scr, kb * 64, nb * 32, F.lane); continue; } r -= I_A;
        if (r < I_S) { const int kb = r / 32, nb = r % 32; p0_transpose_item(a.in[I_WSO], 2048, 1024, (bf16*)(ws + WS_WTS), nb * 32, a.in[I_SNORM], scr, kb * 64, nb * 32, F.lane); continue; } r -= I_S;
        if (r < I_O) { const int kb = r / 32, nb = r % 32; p0_transpose_item(a.in[I_WOUT], 1024, 1024, (bf16*)(ws + WS_WTO), nb * 32, nullptr, scr, kb * 64, nb * 32, F.lane); continue; } r -= I_O;
        if (r < I_U) { const int kb = r / 128, nb = r % 128; p0_transpose_item(a.in[I_WUP], 1024, 4096, (bf16*)(ws + WS_WTU), nb * 32, a.in[I_NMLP], scr, kb * 64, nb * 32, F.lane); continue; } r -= I_U;
        { const int kb = r / 32, nb = r % 32; p0_transpose_item(a.in[I_WDN], 4096, 1024, (bf16*)(ws + WS_WTD), nb * 32, nullptr, scr, kb * 64, nb * 32, F.lane); }
    }
    bf16* XB = (bf16*)(ws + WS_XB);
    for (int m = gw; m < MPAD; m += NGW) {
        GAS unsigned long long* o8 = (GAS unsigned long long*)(XB + (size_t)m * 1024) + F.lane;
        if (m >= MTOK) {
#pragma unroll
            for (int j = 0; j < 4; ++j) o8[64 * j] = 0ull;
            continue;
        }
        const float* xrow = m < MP ? a.in[I_XP] + (size_t)m * 1024 : a.in[I_XS] + (size_t)(m - MP) * 1024;
        const GAS f32x4* xr = (const GAS f32x4*)xrow + F.lane;
        f32x4 v[4]; float s = 0.f;
#pragma unroll
        for (int j = 0; j < 4; ++j) { v[j] = xr[64 * j]; s += (v[j].x * v[j].x + v[j].y * v[j].y) + (v[j].z * v[j].z + v[j].w * v[j].w); }
        const float rstd = 1.f / sqrtf(wave_sum(s) * (1.f / 1024.f) + EPS);
#pragma unroll
        for (int j = 0; j < 4; ++j) o8[64 * j] = (unsigned long long)pk2(v[j].x * rstd, v[j].y * rstd) | ((unsigned long long)pk2(v[j].z * rstd, v[j].w * rstd) << 32);
    }
    const int gt = F.vcu * (NWAVES * 64) + F.tid, NGT = F.G * NWAVES * 64;
    float* rope = (float*)(ws + WS_ROPE);
    for (int e = gt; e < 2049 * 32; e += NGT) {
        const int t = e >> 5, i = e & 31;
        const double ang = (double)(t == 2048 ? 8192 : t) * a.invf[i];
        const double q = rint(ang * 0.63661977236758134308);
        double rr = fma(-q, 1.57079632679489655800, ang); rr = fma(-q, 6.12323399573676603587e-17, rr);
        const double r2 = rr * rr;
        const double sn = rr * (1.0 + r2 * (-1.0 / 6 + r2 * (1.0 / 120 + r2 * (-1.0 / 5040 + r2 * (1.0 / 362880 + r2 * (-1.0 / 39916800 + r2 * (1.0 / 6227020800.0)))))));
        const double cs = 1.0 + r2 * (-0.5 + r2 * (1.0 / 24 + r2 * (-1.0 / 720 + r2 * (1.0 / 40320 + r2 * (-1.0 / 3628800 + r2 * (1.0 / 479001600 + r2 * (-1.0 / 87178291200.0)))))));
        const int qi = ((int)q) & 3;
        const double s = (qi == 0) ? sn : (qi == 1) ? cs : (qi == 2) ? -sn : -cs;
        const double c = (qi == 0) ? cs : (qi == 1) ? -sn : (qi == 2) ? -cs : sn;
        rope[(size_t)t * 64 + i] = (float)c; rope[(size_t)t * 64 + 32 + i] = (float)s;
    }
    {
        const f32x4* ck = (const f32x4*)a.in[I_CK]; const f32x4* cv = (const f32x4*)a.in[I_CV];
        f32x4* ks = (f32x4*)(a.out + O_KS); f32x4* vs = (f32x4*)(a.out + O_VS);
        for (int e = gt; e < 128 * 127 * 64; e += NGT) { const int b = e / (127 * 64), rem = e % (127 * 64); const size_t src = (size_t)b * 128 * 64 + 64 + rem, dst = (size_t)b * 128 * 64 + rem; ks[dst] = ck[src]; vs[dst] = cv[src]; }
        const f32x4* sc = (const f32x4*)a.in[I_SC]; f32x4* cs = (f32x4*)(a.out + O_CS);
        for (int e = gt; e < 128 * 2 * 768; e += NGT) { const int b = e / (2 * 768), rem = e % (2 * 768); cs[(size_t)b * 3 * 768 + rem] = sc[(size_t)b * 3 * 768 + 768 + rem]; }
    }
}

template <bool DECODE>
__device__ __forceinline__ void attn_simple(Frame& F, const Args& a) {
    unsigned char* ws = a.ws;
    const bf16* Q = (const bf16*)(ws + WS_Q); const bf16* Kb = (const bf16*)(ws + WS_K); const bf16* Vb = (const bf16*)(ws + WS_V); bf16* OA = (bf16*)(ws + WS_OA);
    const float* sinks = a.in[I_SINK];
    const int gw = F.vcu * NWAVES + F.wave, NGW = F.G * NWAVES, lane = F.lane;
    const int ntask = (DECODE ? DEC : MP) * NH;
    for (int task = gw; task < ntask; task += NGW) {
        const int rr = task >> 4, h = task & 15, kvh = h >> 2;
        const int r = DECODE ? MP + rr : rr;
        float q[64];
        {
            const u32x4* qp = (const u32x4*)(Q + (size_t)r * 1024 + h * 64);
#pragma unroll
            for (int c = 0; c < 8; ++c) { const u32x4 w = qp[c]; q[8 * c] = bflo(w.x); q[8 * c + 1] = bfhi(w.x); q[8 * c + 2] = bflo(w.y); q[8 * c + 3] = bfhi(w.y); q[8 * c + 4] = bflo(w.z); q[8 * c + 5] = bfhi(w.z); q[8 * c + 6] = bflo(w.w); q[8 * c + 7] = bfhi(w.w); }
        }
        float sA, sB;
        if (DECODE) {
            const float* kbase = a.out + O_KS + (size_t)rr * 128 * 256 + kvh * 64;
            float s0 = 0.f, s1 = 0.f;
            const f32x4* k0 = (const f32x4*)(kbase + (size_t)lane * 256); const f32x4* k1 = (const f32x4*)(kbase + (size_t)(lane + 64) * 256);
#pragma unroll
            for (int c = 0; c < 16; ++c) { const f32x4 x = k0[c], y = k1[c]; s0 += q[4 * c] * x[0] + q[4 * c + 1] * x[1] + q[4 * c + 2] * x[2] + q[4 * c + 3] * x[3]; s1 += q[4 * c] * y[0] + q[4 * c + 1] * y[1] + q[4 * c + 2] * y[2] + q[4 * c + 3] * y[3]; }
            sA = s0; sB = s1;
        } else {
            const int b = r >> 11, t = r & (SEQ - 1);
            const int kA = t - 127 + lane, kB = t - 63 + lane;
            const int rA = b * SEQ + (kA < 0 ? 0 : kA), rB = b * SEQ + (kB < 0 ? 0 : kB);
            const u32x4* pA = (const u32x4*)(Kb + (size_t)rA * 256 + kvh * 64); const u32x4* pB = (const u32x4*)(Kb + (size_t)rB * 256 + kvh * 64);
            float s0 = 0.f, s1 = 0.f;
#pragma unroll
            for (int c = 0; c < 8; ++c) { const u32x4 x = pA[c], y = pB[c];
                s0 += q[8 * c] * bflo(x.x) + q[8 * c + 1] * bfhi(x.x) + q[8 * c + 2] * bflo(x.y) + q[8 * c + 3] * bfhi(x.y) + q[8 * c + 4] * bflo(x.z) + q[8 * c + 5] * bfhi(x.z) + q[8 * c + 6] * bflo(x.w) + q[8 * c + 7] * bfhi(x.w);
                s1 += q[8 * c] * bflo(y.x) + q[8 * c + 1] * bfhi(y.x) + q[8 * c + 2] * bflo(y.y) + q[8 * c + 3] * bfhi(y.y) + q[8 * c + 4] * bflo(y.z) + q[8 * c + 5] * bfhi(y.z) + q[8 * c + 6] * bflo(y.w) + q[8 * c + 7] * bfhi(y.w); }
            sA = kA < 0 ? -INFINITY : s0; sB = kB < 0 ? -INFINITY : s1;
        }
        const float sink = sinks[h];
        const float mx = fmaxf(wave_max(fmaxf(sA, sB)), sink);
        float pA_ = __expf(sA - mx), pB_ = __expf(sB - mx);
        const float den = wave_sum(pA_ + pB_) + __expf(sink - mx);
        const float inv = 1.0f / den; pA_ *= inv; pB_ *= inv;
        float o = 0.f;
        if (DECODE) {
            const float* vbase = a.out + O_VS + (size_t)rr * 128 * 256 + kvh * 64 + lane;
            for (int j = 0; j < 64; ++j) { const float pa = __shfl(pA_, j), pb = __shfl(pB_, j); o += pa * vbase[(size_t)j * 256] + pb * vbase[(size_t)(j + 64) * 256]; }
        } else {
            const int b = r >> 11, t = r & (SEQ - 1);
            for (int j = 0; j < 64; ++j) { const float pa = __shfl(pA_, j), pb = __shfl(pB_, j);
                const int kA = t - 127 + j, kB = t - 63 + j; const int rA = b * SEQ + (kA < 0 ? 0 : kA), rB = b * SEQ + (kB < 0 ? 0 : kB);
                o += pa * bf2f(Vb[(size_t)rA * 256 + kvh * 64 + lane]) + pb * bf2f(Vb[(size_t)rB * 256 + kvh * 64 + lane]); }
        }
        OA[(size_t)r * 1024 + h * 64 + lane] = (bf16)f2bf(o);
    }
}

__device__ __forceinline__ void ssd_simple_prompt(Frame& F, const Args& a) {
    unsigned char* ws = a.ws;
    const bf16* XBC = (const bf16*)(ws + WS_XBC); const bf16* ZS = (const bf16*)(ws + WS_ZS); const float* DT = (const float*)(ws + WS_DT);
    bf16* YZ = (bf16*)(ws + WS_YZ); float* SSQ2 = (float*)(ws + WS_SSQ2);
    const float* cw = a.in[I_CW]; const float* cb = a.in[I_CB];
    LAS float* xs = (LAS float*)(F.lds);
    LAS float* Bs = xs + 64 * 64;
    LAS float* Cs = Bs + 64 * 128;
    LAS float* zs = Cs + 64 * 128;
    LAS float* ys = zs + 64 * 64;
    LAS float* dts = ys + 64 * 64;
    const int tid = F.tid, p = tid >> 3, nq = tid & 7;
    for (int item = F.vcu; item < NB * SH; item += F.G) {
        const int b = item >> 5, hh = item & 31, g = hh >> 3;
        const float A = -__expf(a.in[I_ALOG][hh]), Dk = a.in[I_DSK][hh];
        float h[16];
#pragma unroll
        for (int i = 0; i < 16; ++i) h[i] = 0.f;
        for (int t0 = 0; t0 < SEQ; t0 += 64) {
            for (int e = tid; e < 64 * 320; e += 512) {
                const int tok = e / 320, ch = e % 320;
                const int gch = ch < 64 ? hh * 64 + ch : (ch < 192 ? 2048 + g * 128 + (ch - 64) : 2560 + g * 128 + (ch - 192));
                float acc = cb[gch];
#pragma unroll
                for (int j = 0; j < 4; ++j) { const int tt = t0 + tok - 3 + j; if (tt >= 0) acc += cw[j * 3072 + gch] * bf2f(XBC[(size_t)(b * SEQ + tt) * 3072 + gch]); }
                const float v = siluf_(acc);
                if (ch < 64) xs[tok * 64 + ch] = v; else if (ch < 192) Bs[tok * 128 + ch - 64] = v; else Cs[tok * 128 + ch - 192] = v;
            }
            for (int e = tid; e < 64 * 64; e += 512) { const int tok = e >> 6, pp = e & 63; zs[e] = bf2f(ZS[(size_t)(b * SEQ + t0 + tok) * 2048 + hh * 64 + pp]); }
            if (tid < 64) dts[tid] = DT[(size_t)(b * SEQ + t0 + tid) * 32 + hh];
            __syncthreads();
            for (int tok = 0; tok < 64; ++tok) {
                const float dt = dts[tok], dA = __expf(dt * A), x = xs[tok * 64 + p], dx = dt * x;
                float y = 0.f;
#pragma unroll
                for (int i4 = 0; i4 < 4; ++i4) {
                    const f32x4 bv = *(const LAS f32x4*)(Bs + tok * 128 + nq * 16 + 4 * i4), cv = *(const LAS f32x4*)(Cs + tok * 128 + nq * 16 + 4 * i4);
#pragma unroll
                    for (int e = 0; e < 4; ++e) { h[4 * i4 + e] = dA * h[4 * i4 + e] + dx * bv[e]; y += h[4 * i4 + e] * cv[e]; }
                }
                y += __shfl_xor(y, 1); y += __shfl_xor(y, 2); y += __shfl_xor(y, 4);
                if (nq == 0) ys[tok * 64 + p] = (y + Dk * x) * zs[tok * 64 + p];
            }
            __syncthreads();
            for (int e = tid; e < 64 * 64; e += 512) { const int tok = e >> 6, pp = e & 63; YZ[(size_t)(b * SEQ + t0 + tok) * 2048 + hh * 64 + pp] = (bf16)f2bf(ys[e]); }
            if (tid < 128) { const int tok = tid >> 1, half = tid & 1; float s = 0.f;
                for (int i = 0; i < 32; ++i) { const float v = ys[tok * 64 + half * 32 + i]; s += v * v; }
                SSQ2[(size_t)(b * SEQ + t0 + tok) * 64 + hh * 2 + half] = s; }
            __syncthreads();
        }
        float* hp = a.out + O_HP + ((size_t)(b * SH + hh) * 64 + p) * 128 + nq * 16;
#pragma unroll
        for (int i4 = 0; i4 < 4; ++i4) *(f32x4*)(hp + 4 * i4) = (f32x4){h[4 * i4], h[4 * i4 + 1], h[4 * i4 + 2], h[4 * i4 + 3]};
    }
}

__device__ __forceinline__ void ssd_simple_decode(Frame& F, const Args& a) {
    unsigned char* ws = a.ws;
    const bf16* ZS = (const bf16*)(ws + WS_ZS); const float* DT = (const float*)(ws + WS_DT);
    bf16* YZ = (bf16*)(ws + WS_YZ); float* SSQ2 = (float*)(ws + WS_SSQ2);
    const float* cw = a.in[I_CW]; const float* cb = a.in[I_CB]; const float* sc = a.in[I_SC]; const float* h0 = a.in[I_SS];
    LAS float* xc = (LAS float*)(F.lds);
    LAS float* ys = xc + 320;
    const int tid = F.tid, p = tid >> 3, nq = tid & 7;
    for (int item = F.vcu; item < DEC * SH; item += F.G) {
        const int b = item >> 5, hh = item & 31, g = hh >> 3, r = MP + b;
        if (tid < 320) {
            const int ch = tid; const int gch = ch < 64 ? hh * 64 + ch : (ch < 192 ? 2048 + g * 128 + (ch - 64) : 2560 + g * 128 + (ch - 192));
            float acc = cb[gch];
#pragma unroll
            for (int j = 0; j < 3; ++j) acc += cw[j * 3072 + gch] * sc[((size_t)b * 3 + j) * 3072 + gch];
            acc += cw[3 * 3072 + gch] * a.out[O_CS + ((size_t)b * 3 + 2) * 3072 + gch];
            xc[ch] = siluf_(acc);
        }
        __syncthreads();
        const float dt = DT[(size_t)r * 32 + hh], A = -__expf(a.in[I_ALOG][hh]), dA = __expf(dt * A), x = xc[p], dx = dt * x;
        const float* hin = h0 + ((size_t)(b * SH + hh) * 64 + p) * 128 + nq * 16;
        float* hout = a.out + O_HS + ((size_t)(b * SH + hh) * 64 + p) * 128 + nq * 16;
        float y = 0.f;
#pragma unroll
        for (int i4 = 0; i4 < 4; ++i4) {
            f32x4 hv = *(const f32x4*)(hin + 4 * i4);
#pragma unroll
            for (int e = 0; e < 4; ++e) { hv[e] = dA * hv[e] + dx * xc[64 + nq * 16 + 4 * i4 + e]; y += hv[e] * xc[192 + nq * 16 + 4 * i4 + e]; }
            *(f32x4*)(hout + 4 * i4) = hv;
        }
        y += __shfl_xor(y, 1); y += __shfl_xor(y, 2); y += __shfl_xor(y, 4);
        if (nq == 0) { const float yz = (y + a.in[I_DSK][hh] * x) * bf2f(ZS[(size_t)r * 2048 + hh * 64 + p]); ys[p] = yz; YZ[(size_t)r * 2048 + hh * 64 + p] = (bf16)f2bf(yz); }
        __syncthreads();
        if (tid < 2) { float s = 0.f; for (int i = 0; i < 32; ++i) { const float v = ys[tid * 32 + i]; s += v * v; } SSQ2[(size_t)r * 64 + hh * 2 + tid] = s; }
        __syncthreads();
    }
}

__global__ void __launch_bounds__(NWAVES * 64, 2) hybrid_fwd(Args args) {
    extern __shared__ __attribute__((aligned(16))) unsigned char lds[];
    Frame F;
    F.lds = (LAS unsigned char*)lds;
    volatile LAS unsigned* MISC = (volatile LAS unsigned*)(F.lds + MISC_OFF);
    F.tid = threadIdx.x; F.lane = F.tid & 63; F.wave = __builtin_amdgcn_readfirstlane(F.tid >> 6);
    F.G = gridDim.x; { const int bx = blockIdx.x; F.vcu = (F.G % 8 == 0) ? (bx % 8) * (F.G / 8) + bx / 8 : bx; }
    unsigned char* ws = args.ws;
    gu32* ctl = (gu32*)(ws + WS_CTL);
    for (int u = F.tid; u < (LDS_BYTES - LDSCTL_OFF) / 4; u += NWAVES * 64) ((LAS unsigned*)(F.lds + LDSCTL_OFF))[u] = 0u;
    __syncthreads();
    XcdBarrier bar = xcd_barrier_post((unsigned*)(ctl + CW_BAR), MISC + 8);
    const int lo = args.ph_lo, hi = args.ph_hi;
#define IN(k) (lo <= (k) && (k) < hi)
#define BOTH(k) (IN(k) && IN((k) + 1))
#define GRID_BAR() xcd_barrier(bar)

    bf16* WT1 = (bf16*)(ws + WS_WT1); bf16* WTA = (bf16*)(ws + WS_WTA); bf16* WTS = (bf16*)(ws + WS_WTS); bf16* WTO = (bf16*)(ws + WS_WTO); bf16* WTU = (bf16*)(ws + WS_WTU); bf16* WTD = (bf16*)(ws + WS_WTD);
    bf16* XB = (bf16*)(ws + WS_XB); bf16* Qb = (bf16*)(ws + WS_Q); bf16* Kb = (bf16*)(ws + WS_K); bf16* Vb = (bf16*)(ws + WS_V); bf16* OA = (bf16*)(ws + WS_OA);
    bf16* YZ = (bf16*)(ws + WS_YZ); bf16* GT = (bf16*)(ws + WS_GT); bf16* ZS = (bf16*)(ws + WS_ZS); bf16* XBC = (bf16*)(ws + WS_XBC);
    float* DT = (float*)(ws + WS_DT); float* SSQ2 = (float*)(ws + WS_SSQ2); float* SSQ3 = (float*)(ws + WS_SSQ3); float* ROPE = (float*)(ws + WS_ROPE);
    float* T1 = (float*)(ws + WS_ZS); bf16* MIX = XB; bf16* X1B = OA; bf16* ACT = ZS;

    if (IN(0)) { p0_prologue(F, args); if (BOTH(0)) GRID_BAR(); }
    if (IN(1)) {
        pg8::Gemm g{XB, WT1, MPAD, N1, 1024}; pg8::StaticOrder S; S.init(MPAD, N1, F.G, (int)blockIdx.x);
        EpiIn E{Qb, Kb, Vb, ZS, XBC, GT, DT, args.out, ROPE, args.in[I_QN], args.in[I_KN], args.in[I_DTB]};
        pg8::gemm_phase<EpiIn, pg8::StaticOrder, true, true>(F.lds + RING_OFF, g, S, E);
        if (BOTH(1)) GRID_BAR();
    }
    if (IN(2)) {
        ssd_simple_decode(F, args);
        attn_simple<true>(F, args);
        attn_simple<false>(F, args);
        ssd_simple_prompt(F, args);
        if (BOTH(2)) GRID_BAR();
    }
    if (IN(3)) {
        { pg8::Gemm g{OA, WTA, MPAD, 1024, 1024}; pg8::StaticOrder S; S.init(MPAD, 1024, F.G, (int)blockIdx.x);
          EpiT1 E{GT, T1};
          pg8::gemm_phase<EpiT1, pg8::StaticOrder, true, true>(F.lds + RING_OFF, g, S, E); }
        { pg8::Gemm g{YZ, WTS, MPAD, 1024, 2048}; pg8::StaticOrder S; S.init(MPAD, 1024, F.G, (int)blockIdx.x);
          EpiMix E{GT, T1, SSQ2, MIX};
          pg8::gemm_phase<EpiMix, pg8::StaticOrder, true, true>(F.lds + RING_OFF, g, S, E); }
        if (BOTH(3)) GRID_BAR();
    }
    if (IN(4)) {
        pg8::Gemm g{MIX, WTO, MPAD, 1024, 1024}; pg8::StaticOrder S; S.init(MPAD, 1024, F.G, (int)blockIdx.x);
        EpiRes1 E{args.in[I_XP], args.in[I_XS], args.out, X1B, SSQ3};
        pg8::gemm_phase<EpiRes1, pg8::StaticOrder, true, true>(F.lds + RING_OFF, g, S, E);
        if (BOTH(4)) GRID_BAR();
    }
    if (IN(5)) {
        pg8::Gemm g{X1B, WTU, MPAD, 4096, 1024}; pg8::StaticOrder S; S.init(MPAD, 4096, F.G, (int)blockIdx.x);
        EpiUp E{SSQ3, ACT};
        pg8::gemm_phase<EpiUp, pg8::StaticOrder, true, true>(F.lds + RING_OFF, g, S, E);
        if (BOTH(5)) GRID_BAR();
    }
    if (IN(6)) {
        pg8::Gemm g{ACT, WTD, MPAD, 1024, 4096}; pg8::StaticOrder S; S.init(MPAD, 1024, F.G, (int)blockIdx.x);
        EpiDown E{args.out};
        pg8::gemm_phase<EpiDown, pg8::StaticOrder, true, true>(F.lds + RING_OFF, g, S, E);
    }
#undef IN
#undef BOTH
#undef GRID_BAR
}

#ifndef MK_N_LAUNCHES
#define MK_N_LAUNCHES 1
#endif
extern "C" void kernel_launch(void* const* d_in, const int* in_sizes, int n_in, void* d_out, int out_size, void* d_ws, size_t ws_size, hipStream_t stream) {
    static int grid = 0;
    if (grid == 0) {
        if (n_in != 23 || ws_size < WS_END || out_size != 62726144) { fprintf(stderr, "kernel_launch: unexpected n_in %d / ws %zu / out %d; nothing launched\n", n_in, ws_size, out_size); grid = -1; return; }
        int dev = 0, cus = 0, per_cu = 0;
        if (hipGetDevice(&dev) != hipSuccess || hipDeviceGetAttribute(&cus, hipDeviceAttributeMultiprocessorCount, dev) != hipSuccess) { grid = -1; return; }
        if (hipFuncSetAttribute((const void*)hybrid_fwd, hipFuncAttributeMaxDynamicSharedMemorySize, LDS_BYTES) != hipSuccess) { fprintf(stderr, "kernel_launch: hipFuncSetAttribute failed\n"); grid = -1; return; }
        if (hipOccupancyMaxActiveBlocksPerMultiprocessor(&per_cu, (const void*)hybrid_fwd, NWAVES * 64, LDS_BYTES) != hipSuccess || per_cu < 1) { fprintf(stderr, "kernel_launch: occupancy query reports %d blocks per CU\n", per_cu); per_cu = 1; }
        (void)hipGetLastError();
        grid = cus;
    }
    if (grid < 0) return;
    if (hipMemsetAsync((char*)d_ws + WS_CTL, 0, CTL_ZERO_BYTES, stream) != hipSuccess) { fprintf(stderr, "kernel_launch: memset failed\n"); return; }
    Args a{};
    for (int i = 0; i < 23; ++i) a.in[i] = (const float*)d_in[i];
    a.out = (float*)d_out; a.ws = (unsigned char*)d_ws;
    for (int i = 0; i < 32; ++i) a.invf[i] = pow(10000.0, -(double)i / 32.0);
#if MK_N_LAUNCHES == 1
    a.ph_lo = 0; a.ph_hi = 7;
    void* kargs[] = {&a};
    hipError_t e = hipLaunchCooperativeKernel((const void*)hybrid_fwd, dim3(grid), dim3(NWAVES * 64), kargs, LDS_BYTES, stream);
    if (e != hipSuccess) fprintf(stderr, "kernel_launch: cooperative launch failed: %s (grid %d)\n", hipGetErrorString(e), grid);
#else
    for (int li = 0; li < 7; ++li) { a.ph_lo = li; a.ph_hi = li + 1; hipLaunchKernelGGL(hybrid_fwd, dim3(grid), dim3(NWAVES * 64), LDS_BYTES, stream, a); }
#endif
}
```

```cpp
#include <hip/hip_runtime.h>
#include <cstdio>
#include <cstdint>
#include <cmath>
#define REP_MASK 0
#define PROBE_ID 0
#define PROBE_MAX 0

#define LAS __attribute__((address_space(3)))
constexpr int LDS_BYTES = 163840;
constexpr int LDSCTL_OFF = LDS_BYTES - 512, MISC_OFF = LDSCTL_OFF + 320;
#ifndef PROBE_ID
#define PROBE_ID 0
#endif
#define P_BEGIN(id, ldsp, wv) do { if (PROBE_ID == (id) && (wv) == 0) *(LAS unsigned long long*)((ldsp) + MISC_OFF + 64) = __builtin_amdgcn_s_memrealtime(); } while (0)
#define P_END(id, ldsp, wv) do { if (PROBE_ID == (id) && (wv) == 0) *(LAS float*)((ldsp) + MISC_OFF + 72) += (float)(__builtin_amdgcn_s_memrealtime() - *(LAS unsigned long long*)((ldsp) + MISC_OFF + 64)); } while (0)
#define P_ENDMAX(id, ldsp, wv) do { if (PROBE_ID == (id) && (wv) == 0) { const float d_ = (float)(__builtin_amdgcn_s_memrealtime() - *(LAS unsigned long long*)((ldsp) + MISC_OFF + 64)); LAS float* a_ = (LAS float*)((ldsp) + MISC_OFF + 72); *a_ = fmaxf(*a_, d_); } } while (0)
namespace pg8 {
#define PG8_LAS __attribute__((address_space(3)))
typedef unsigned short bf16_t;
typedef short bf16x8 __attribute__((ext_vector_type(8)));
typedef float f32x4 __attribute__((ext_vector_type(4)));
typedef unsigned u32x4 __attribute__((ext_vector_type(4)));
constexpr int BM = 256, BK = 64, HALF = 128, HTB = HALF * BK * 2  , STAGE_BYTES = 8 * HTB, NXCD = 8, WGM = 7;

__host__ __device__ __forceinline__ int lds_byte(int r, int c) { const int st = (r >> 4) * 2 + (c >> 5), rr = r & 15, cc = c & 31, ob = rr * 64 + cc * 2; return st * 1024 + (ob ^ (((ob >> 9) & 1) << 5)); }
__host__ __device__ __forceinline__ void stage_rc(int b, int& R, int& C) { const int st = b / 1024, sb = b % 1024, swz = sb ^ (((sb >> 9) & 1) << 5); R = (st >> 1) * 16 + swz / 64; C = (st & 1) * 32 + (swz % 64) / 2; }
__host__ __device__ __forceinline__ int perm32(int rho) { const int n = rho >> 4, i = rho & 15; return 8 * (i >> 2) + 4 * n + (i & 3); }

struct Unit { int pm, pn; };
struct Gemm { const bf16_t* A; const bf16_t* Bt; int M, N, K; };

struct StaticOrder {
    int nM, nN, nwg, G, c, wgm;
    __host__ __device__ void init(int M, int N, int G_, int c_, int wgm_ = WGM) { nM = M / BM; nN = N / BM; nwg = nM * nN; G = G_; c = c_; wgm = wgm_; }
    __host__ __device__ bool next(int i, Unit& u) const {
        const long L = (long)i * G + c; if (L >= nwg) return false;
        int wgid = (int)L; { const int q = nwg / NXCD, r = nwg % NXCD, xcd = wgid % NXCD, off = wgid / NXCD; wgid = (xcd < r ? xcd * (q + 1) : r * (q + 1) + (xcd - r) * q) + off; }
        const int nig = wgm * nN, gid = wgid / nig, fm = gid * wgm, gsz = (nM - fm) < wgm ? (nM - fm) : wgm;
        u.pm = fm + ((wgid % nig) % gsz); u.pn = (wgid % nig) / gsz; return true;
    }
    __device__ __forceinline__ void a_ready(const Unit&) const {}
    __device__ __forceinline__ void done(const Unit&) const {}
};

__device__ __forceinline__ unsigned cvt_pk_bf16(float lo, float hi) { unsigned r; asm volatile("v_cvt_pk_bf16_f32 %0, %1, %2" : "=v"(r) : "v"(lo), "v"(hi)); return r; }
typedef float f32x2 __attribute__((ext_vector_type(2)));
template <class Epi, class Sched, bool ALIGN_EPI = false, bool SP2 = false, bool APERM = false>
__device__ __forceinline__ void gemm_phase(PG8_LAS unsigned char* lds, const Gemm g, const Sched& S, const Epi& E, const int wid_in) {
    int lane_ = (int)__builtin_amdgcn_mbcnt_hi(~0u, __builtin_amdgcn_mbcnt_lo(~0u, 0u)); asm volatile("" : "+v"(lane_));
    const int wid = wid_in, lane = lane_, tid = wid * 64 + lane, wr = wid >> 2, wc = wid & 3, fr = lane & 15, fq = lane >> 4;
    const int K = g.K, nt = K / BK;
    unsigned voffA[2], voffB[2];
#pragma unroll
    for (int i = 0; i < 2; ++i) { int R, C; stage_rc(tid * 16 + i * 8192, R, C); const int Rb = Epi::PERM ? ((R & ~31) + perm32(R & 31)) : R;
        const int Ra = APERM ? ((R >> 6) * 128 + (R & 15) * 8 + ((R >> 4) & 3)) : R;
        voffA[i] = (unsigned)(Ra * K + C) * 2u; voffB[i] = (unsigned)(Rb * K + C) * 2u; }
    const size_t kstep = (size_t)(BK * 2);
    const size_t hstep = (size_t)HALF * K * 2;
    const size_t hstepA = APERM ? (size_t)4 * K * 2 : hstep;
    const size_t tstep = 2 * hstep;
    const unsigned ldsw = (unsigned)wid * 1024u;
    const int aoff = lds_byte(wr * 64 + fr, fq * 8), boff = lds_byte(wc * 32 + fr, fq * 8);
#define PG8_SA(b, h) (((b) * 2 + (h)) * HTB)
#define PG8_SB(b, h) ((4 + (b) * 2 + (h)) * HTB)
#define PG8_STAGE(bufoff, gbase, voff) do { _Pragma("unroll") for (int _i = 0; _i < 2; ++_i) \
        __builtin_amdgcn_global_load_lds((const unsigned*)((const char*)(gbase) + (voff)[_i]), (PG8_LAS unsigned*)(lds + (bufoff) + ldsw + _i * 8192), 16, 0, 0); } while (0)
#define PG8_LDA(dst, b, h) do { _Pragma("unroll") for (int m = 0; m < 4; ++m) _Pragma("unroll") for (int k = 0; k < 2; ++k) dst[m][k] = *(const PG8_LAS bf16x8*)(lds + PG8_SA(b, h) + aoff + m * 2048 + k * 1024); } while (0)
#define PG8_LDB(dst, b, h) do { _Pragma("unroll") for (int n = 0; n < 2; ++n) _Pragma("unroll") for (int k = 0; k < 2; ++k) dst[n][k] = *(const PG8_LAS bf16x8*)(lds + PG8_SB(b, h) + boff + n * 2048 + k * 1024); } while (0)
#define PG8_MMA(ai, bj, At, Bt) do { __builtin_amdgcn_s_setprio(1); _Pragma("unroll") for (int m = 0; m < 4; ++m) _Pragma("unroll") for (int n = 0; n < 2; ++n) _Pragma("unroll") for (int k = 0; k < 2; ++k) \
        acc[ai][bj][m][n] = __builtin_amdgcn_mfma_f32_16x16x32_bf16(Bt[n][k], At[m][k], acc[ai][bj][m][n], 0, 0, 0); __builtin_amdgcn_s_setprio(0); } while (0)
#define PG8_WAIT_V(n) asm volatile("s_waitcnt vmcnt(" #n ")" ::: "memory")
#define PG8_WAIT_L(n) asm volatile("s_waitcnt lgkmcnt(" #n ")" ::: "memory")
#define PG8_BAR __builtin_amdgcn_s_barrier()
#define PG8_SCHED __builtin_amdgcn_sched_barrier(0)
    Unit cur, nxt; int ui = 0;
    if (!S.next(0, cur)) return;
    f32x4 acc[2][2][4][2];
#pragma unroll
    for (int a = 0; a < 2; ++a)
#pragma unroll
        for (int b = 0; b < 2; ++b)
#pragma unroll
            for (int m = 0; m < 4; ++m)
#pragma unroll
                for (int n = 0; n < 2; ++n) acc[a][b][m][n] = (f32x4){0.f, 0.f, 0.f, 0.f};
    bf16x8 At[4][2], B0[2][2], B1[2][2];
    const char* cA = (const char*)g.A + (size_t)cur.pm * tstep; const char* cB = (const char*)g.Bt + (size_t)cur.pn * tstep;
    S.a_ready(cur);
    if constexpr (SP2) {
        PG8_STAGE(PG8_SB(0, 0), cB, voffB); PG8_STAGE(PG8_SB(0, 1), cB + hstep, voffB); PG8_STAGE(PG8_SA(0, 0), cA, voffA); PG8_STAGE(PG8_SA(0, 1), cA + hstepA, voffA);
        if (wr == 1) PG8_BAR;
        PG8_WAIT_V(2); PG8_BAR;
        PG8_STAGE(PG8_SB(1, 0), cB + kstep, voffB); PG8_STAGE(PG8_SA(1, 0), cA + kstep, voffA); PG8_STAGE(PG8_SB(1, 1), cB + hstep + kstep, voffB);
        PG8_WAIT_V(6); PG8_BAR;
    } else {
        PG8_STAGE(PG8_SB(0, 0), cB, voffB); PG8_STAGE(PG8_SA(0, 0), cA, voffA); PG8_STAGE(PG8_SB(0, 1), cB + hstep, voffB); PG8_STAGE(PG8_SA(0, 1), cA + hstepA, voffA);
        if (wr == 1) PG8_BAR;
        PG8_WAIT_V(4); PG8_BAR;
        PG8_STAGE(PG8_SB(1, 0), cB + kstep, voffB); PG8_STAGE(PG8_SA(1, 0), cA + kstep, voffA); PG8_STAGE(PG8_SB(1, 1), cB + hstep + kstep, voffB);
        PG8_WAIT_V(6); PG8_BAR;
    }
    for (;;) {
        const bool has_next = S.next(ui + 1, nxt);
        const char* nA = has_next ? (const char*)g.A + (size_t)nxt.pm * tstep : cA; const char* nB = has_next ? (const char*)g.Bt + (size_t)nxt.pn * tstep : cB;
        for (int t = 0; t < nt; t += 2) {
            if constexpr (Epi::MIDT > 0) { if (t == Epi::MIDT) E.mid(acc, cur, wr, wc, fr, fq); }
            const bool last = (t == nt - 2);
            const char* a1 = cA + (size_t)(t + 1) * kstep;
            const char* a2 = last ? nA : cA + (size_t)(t + 2) * kstep; const char* b2 = last ? nB : cB + (size_t)(t + 2) * kstep;
            const char* a3 = a2 + kstep; const char* b3 = b2 + kstep;
            if (last && has_next) S.a_ready(nxt);
            if constexpr (SP2) {
            PG8_LDB(B0, 0, 0); PG8_LDB(B1, 0, 1); PG8_SCHED; PG8_LDA(At, 0, 0); PG8_STAGE(PG8_SA(1, 1), a1 + hstepA, voffA);
            PG8_WAIT_V(8); PG8_WAIT_L(0); PG8_BAR; PG8_MMA(0, 0, At, B0); PG8_MMA(0, 1, At, B1); PG8_BAR; PG8_SCHED;
            PG8_LDA(At, 0, 1); PG8_STAGE(PG8_SB(0, 0), b2, voffB); PG8_STAGE(PG8_SB(0, 1), b2 + hstep, voffB); PG8_STAGE(PG8_SA(0, 0), a2, voffA);
            PG8_WAIT_V(8); PG8_WAIT_L(0); PG8_BAR; PG8_MMA(1, 0, At, B0); PG8_MMA(1, 1, At, B1); PG8_BAR; PG8_SCHED;
            PG8_LDB(B0, 1, 0); PG8_LDB(B1, 1, 1); PG8_SCHED; PG8_LDA(At, 1, 0); PG8_STAGE(PG8_SA(0, 1), a2 + hstepA, voffA);
            PG8_WAIT_V(8); PG8_WAIT_L(0); PG8_BAR; PG8_MMA(0, 0, At, B0); PG8_MMA(0, 1, At, B1); PG8_BAR; PG8_SCHED;
            PG8_LDA(At, 1, 1); PG8_STAGE(PG8_SB(1, 0), b3, voffB); PG8_STAGE(PG8_SB(1, 1), b3 + hstep, voffB); PG8_STAGE(PG8_SA(1, 0), a3, voffA);
            PG8_WAIT_V(8); PG8_WAIT_L(0); PG8_BAR; PG8_MMA(1, 0, At, B0); PG8_MMA(1, 1, At, B1); PG8_BAR; PG8_SCHED;
            } else {
            PG8_LDB(B0, 0, 0); PG8_SCHED; PG8_LDA(At, 0, 0); PG8_STAGE(PG8_SA(1, 1), a1 + hstepA, voffA);
            PG8_WAIT_L(8); PG8_BAR; PG8_WAIT_L(0); PG8_MMA(0, 0, At, B0); PG8_BAR; PG8_SCHED;
            PG8_LDB(B1, 0, 1); PG8_STAGE(PG8_SB(0, 0), b2, voffB);
            PG8_BAR; PG8_WAIT_L(0); PG8_MMA(0, 1, At, B1); PG8_BAR;
            PG8_LDA(At, 0, 1); PG8_STAGE(PG8_SA(0, 0), a2, voffA);
            PG8_BAR; PG8_WAIT_L(0); PG8_MMA(1, 0, At, B0); PG8_BAR; PG8_SCHED;
            PG8_STAGE(PG8_SB(0, 1), b2 + hstep, voffB);
            PG8_WAIT_V(6); PG8_BAR; PG8_MMA(1, 1, At, B1); PG8_BAR;
            PG8_LDB(B0, 1, 0); PG8_SCHED; PG8_LDA(At, 1, 0); PG8_STAGE(PG8_SA(0, 1), a2 + hstepA, voffA);
            PG8_WAIT_L(8); PG8_BAR; PG8_WAIT_L(0); PG8_MMA(0, 0, At, B0); PG8_BAR; PG8_SCHED;
            PG8_LDB(B1, 1, 1); PG8_STAGE(PG8_SB(1, 0), b3, voffB);
            PG8_BAR; PG8_WAIT_L(0); PG8_MMA(0, 1, At, B1); PG8_BAR;
            PG8_LDA(At, 1, 1); PG8_STAGE(PG8_SA(1, 0), a3, voffA);
            PG8_BAR; PG8_WAIT_L(0); PG8_MMA(1, 0, At, B0); PG8_BAR; PG8_SCHED;
            PG8_STAGE(PG8_SB(1, 1), b3 + hstep, voffB);
            PG8_WAIT_V(6); PG8_BAR; PG8_MMA(1, 1, At, B1); PG8_BAR;
            }
        }
        if constexpr (ALIGN_EPI) { if (wr == 0) PG8_BAR; }
        if constexpr (!Epi::AFTER_DRAIN) { P_BEGIN(40 + Epi::PID, lds, wid); E(acc, cur, wr, wc, fr, fq); P_END(40 + Epi::PID, lds, wid); S.done(cur); }
        if (!has_next) break;
#pragma unroll
        for (int a = 0; a < 2; ++a)
#pragma unroll
            for (int b = 0; b < 2; ++b)
#pragma unroll
                for (int m = 0; m < 4; ++m)
#pragma unroll
                    for (int n = 0; n < 2; ++n) acc[a][b][m][n] = (f32x4){0.f, 0.f, 0.f, 0.f};
        cur = nxt; cA = nA; cB = nB; ++ui;
        if constexpr (ALIGN_EPI) { if (wr == 1) PG8_BAR; }
    }
    PG8_WAIT_V(0);
    if constexpr (!ALIGN_EPI) { if (wr == 0) PG8_BAR; }
    PG8_BAR;
    if constexpr (Epi::AFTER_DRAIN) { E.fused(acc, cur, wr, wc, fr, fq, lds, wid, lane); S.done(cur); }
#undef PG8_SA
#undef PG8_SB
#undef PG8_STAGE
#undef PG8_LDA
#undef PG8_LDB
#undef PG8_MMA
#undef PG8_WAIT_V
#undef PG8_WAIT_L
#undef PG8_BAR
#undef PG8_SCHED
}
}
#define GAS __attribute__((address_space(1)))
#define LAS __attribute__((address_space(3)))
typedef unsigned short bf16;
typedef unsigned v4u __attribute__((ext_vector_type(4)));
typedef float f32x4 __attribute__((ext_vector_type(4)));
typedef short bf16x8 __attribute__((ext_vector_type(8)));
typedef GAS unsigned gu32;
typedef GAS unsigned long long gu64;
#define RLX_AGENT __ATOMIC_RELAXED, __HIP_MEMORY_SCOPE_AGENT
#define LDS_WAIT() asm volatile("s_waitcnt lgkmcnt(0)" ::: "memory")
#define VM_WAIT() asm volatile("s_waitcnt vmcnt(0)" ::: "memory")
__device__ __forceinline__ unsigned long long rt() { return __builtin_amdgcn_s_memrealtime(); }
__device__ __forceinline__ unsigned f2bf(float f) { unsigned u = __builtin_bit_cast(unsigned, f); return (u + 0x7fffu + ((u >> 16) & 1u)) >> 16; }
__device__ __forceinline__ unsigned pk2(float lo, float hi) { return f2bf(lo) | (f2bf(hi) << 16); }

#define XB_TMO      128
#define XB_XCNT(j)  (256  + 64 * (j))
#define XB_XSUB(j)  (1280 + 64 * (j))
#define XB_XGEN(j)  (2304 + 64 * (j))
#define XB_TOP      3328
#define XB_TOPGEN   3392
#define XCD_BAR_WORDS 3456
#define XB_SPIN_CAP (1u << 18)

__device__ __forceinline__ unsigned xb_ld(unsigned* p)              { return __hip_atomic_load(p, __ATOMIC_RELAXED, __HIP_MEMORY_SCOPE_AGENT); }
__device__ __forceinline__ unsigned xb_add(unsigned* p, unsigned v) { return __hip_atomic_fetch_add(p, v, __ATOMIC_RELAXED, __HIP_MEMORY_SCOPE_AGENT); }
__device__ __forceinline__ unsigned xb_xcc_id() { return (unsigned)__builtin_amdgcn_s_getreg((3 << 11) | 20) & 0xFu; }
#define XB_SPIN(cond, bar) do { unsigned _sp = 0; while (cond) { __builtin_amdgcn_s_sleep(1); \
    if ((++_sp & 255u) == 0u) { if (xb_ld(&(bar)[XB_TMO])) break; if (_sp > XB_SPIN_CAP) { atomicAdd(&(bar)[XB_TMO], 1u); break; } } } } while (0)

struct XcdBarrier {
    unsigned* bar; unsigned x;
    volatile LAS unsigned* st;
};

__device__ __forceinline__ XcdBarrier xcd_barrier_post(unsigned* bar, volatile LAS unsigned* st) {
    XcdBarrier b; b.bar = bar; b.x = xb_xcc_id(); b.st = st;
    if (threadIdx.x == 0) (void)xb_add(&bar[XB_XCNT(b.x)], 1u);
    return b;
}
__device__ __forceinline__ void xcd_barrier_complete(unsigned* bar, unsigned x, unsigned& nloc, unsigned& nx) {
    const unsigned G = gridDim.x * gridDim.y * gridDim.z;
    unsigned sum, cnt, mine, sp = 0u;
    for (;;) {
        sum = 0u; cnt = 0u; mine = 0u;
#pragma unroll
        for (unsigned j = 0; j < 16; ++j) { const unsigned c = xb_ld(&bar[XB_XCNT(j)]); sum += c; cnt += (c > 0u) ? 1u : 0u; mine = (j == x) ? c : mine; }
        if (sum == G) break;
        __builtin_amdgcn_s_sleep(1);
        if ((++sp & 255u) == 0u) { if (xb_ld(&bar[XB_TMO])) break; if (sp > XB_SPIN_CAP) { atomicAdd(&bar[XB_TMO], 1u); break; } }
    }
    nloc = mine > 0u ? mine : 1u; nx = cnt > 0u ? cnt : 1u;
}

__device__ __forceinline__ void xcd_barrier(const XcdBarrier& b) {
    asm volatile("s_waitcnt vmcnt(0)" ::: "memory");
    __syncthreads();
    if (threadIdx.x == 0) {
        unsigned* bar = b.bar;
        __builtin_amdgcn_s_waitcnt(0);
        unsigned nloc = b.st[0], nx = b.st[1];
        if (nloc == 0u) { xcd_barrier_complete(bar, b.x, nloc, nx); b.st[0] = nloc; b.st[1] = nx; }
        const unsigned old = xb_add(&bar[XB_XSUB(b.x)], 1u);
        const unsigned gen = old / nloc;
        if (old + 1u == (gen + 1u) * nloc) {
            __builtin_amdgcn_fence(__ATOMIC_RELEASE, "agent");
            asm volatile("s_waitcnt vmcnt(0)" ::: "memory");
            const unsigned og = xb_add(&bar[XB_TOP], 1u);
            const unsigned tg = og / nx;
            if (og + 1u == (tg + 1u) * nx) xb_add(&bar[XB_TOPGEN], 1u);
            else XB_SPIN(xb_ld(&bar[XB_TOPGEN]) == tg, bar);
            __builtin_amdgcn_fence(__ATOMIC_ACQUIRE, "agent");
            xb_add(&bar[XB_XGEN(b.x)], 1u);
            asm volatile("s_waitcnt vmcnt(0)" ::: "memory");
        } else {
            XB_SPIN(xb_ld(&bar[XB_XGEN(b.x)]) == gen, bar);
            __builtin_amdgcn_fence(__ATOMIC_ACQUIRE, "agent");
            asm volatile("s_waitcnt vmcnt(0)" ::: "memory");
        }
    }
    __syncthreads();
}

constexpr int NWAVES = 8;
constexpr int DM = 1024, NB = 8, SEQ = 2048, MP = NB * SEQ, DEC = 128, MTOK = MP + DEC, MPAD = 16640;
constexpr int NH = 16, KVH = 4, HD = 64, WIN = 128;
constexpr int DI = 2048, SH = 32, SP = 64, SG = 4, SN = 128, CONVD = 3072, FF = 4096;
constexpr int XROWS = SEQ + 8;
constexpr int N1 = 8960;
constexpr float EPS = 1e-6f;
constexpr size_t O_YP = 0, O_YS = 16777216, O_KP = 16908288, O_VP = 17170432, O_CP = 17432576, O_HP = 17506304, O_KS = 19603456, O_VS = 23797760, O_CS = 27992064, O_HS = 29171712;

constexpr size_t MiB = 1u << 20;
constexpr size_t WS_CTL = 0, CTL_ZERO_BYTES = 32768;
constexpr size_t WS_WT1 = 1 * MiB;
constexpr size_t WS_WTA = 19 * MiB;
constexpr size_t WS_WTS = 21 * MiB;
constexpr size_t WS_WTO = 25 * MiB;
constexpr size_t WS_WTU = 27 * MiB;
constexpr size_t WS_WTD = 35 * MiB;
constexpr size_t WS_ROPE = 43 * MiB;
constexpr size_t WS_DT = 44 * MiB;
constexpr size_t WS_SSQ2 = 47 * MiB;
constexpr size_t WS_SSQ3 = 52 * MiB;
constexpr size_t WS_XB = 54 * MiB;
constexpr size_t WS_Q = 87 * MiB;
constexpr size_t WS_K = 120 * MiB;
constexpr size_t WS_V = 129 * MiB;
constexpr size_t WS_OA = 138 * MiB;
constexpr size_t WS_YZ = 171 * MiB;
constexpr size_t WS_GT = 236 * MiB;
constexpr size_t WS_ZS = 301 * MiB;
constexpr size_t WS_XBC = 366 * MiB;
constexpr size_t WS_HALO = 464 * MiB;
constexpr size_t WS_END = 470 * MiB;
static_assert(WS_XB + (size_t)MPAD * 1024 * 2 <= WS_Q && WS_Q + (size_t)MPAD * 1024 * 2 <= WS_K && WS_K + (size_t)MPAD * 256 * 2 <= WS_V && WS_V + (size_t)MPAD * 256 * 2 <= WS_OA, "ws map 1");
static_assert(WS_OA + (size_t)MPAD * 1024 * 2 <= WS_YZ && WS_YZ + (size_t)MPAD * 2048 * 2 <= WS_GT && WS_GT + (size_t)MPAD * 2048 * 2 <= WS_ZS && WS_ZS + (size_t)MPAD * 2048 * 2 <= WS_XBC && WS_XBC + (size_t)MPAD * 3072 * 2 <= WS_END, "ws map 2");
static_assert(WS_ZS + (size_t)MPAD * 4096 * 2 <= WS_END && WS_WT1 + (size_t)N1 * 1024 * 2 <= WS_WTA && WS_DT + (size_t)MPAD * 32 * 4 <= WS_SSQ2 && WS_SSQ2 + (size_t)MPAD * 64 * 4 <= WS_SSQ3 && WS_SSQ3 + (size_t)MPAD * 16 * 4 <= WS_XB, "ws map 3");
constexpr int CW_TMO = 0, CW_BAR = 4096;

constexpr int RING_OFF = 0, RING_BYTES = 131072;

__device__ __forceinline__ float bf2f(unsigned short b) { return __uint_as_float((unsigned)b << 16); }
__device__ __forceinline__ float bflo(unsigned w) { return __uint_as_float(w << 16); }
__device__ __forceinline__ float bfhi(unsigned w) { return __uint_as_float(w & 0xffff0000u); }
__device__ __forceinline__ float frcp_(float v) { return __builtin_amdgcn_rcpf(v); }
__device__ __forceinline__ float frsq_(float v) { return __builtin_amdgcn_rsqf(v); }
__device__ __forceinline__ float sigmoidf_(float v) { return frcp_(1.0f + __expf(-v)); }
__device__ __forceinline__ float siluf_(float v) { return v * frcp_(1.0f + __expf(-v)); }
__device__ __forceinline__ f32x4 sigmoid4_(f32x4 v) { const f32x4 t = v * -1.4426950408889634f; f32x4 e; e[0] = __builtin_amdgcn_exp2f(t[0]); e[1] = __builtin_amdgcn_exp2f(t[1]); e[2] = __builtin_amdgcn_exp2f(t[2]); e[3] = __builtin_amdgcn_exp2f(t[3]);
    const f32x4 d = e + 1.0f; f32x4 r; r[0] = frcp_(d[0]); r[1] = frcp_(d[1]); r[2] = frcp_(d[2]); r[3] = frcp_(d[3]); return r; }
__device__ __forceinline__ f32x4 silu4_(f32x4 v) { return v * sigmoid4_(v); }

#ifndef REP_MASK
#define REP_MASK 0
#endif
__device__ __forceinline__ int rep_count(int n) { asm volatile("" : "+s"(n)); return n; }
#define REPS(bit) rep_count((((REP_MASK) >> (bit)) & 1) ? 2 : 1)
__device__ __forceinline__ float sum_fq(float v) {
    v += __uint_as_float((unsigned)__builtin_amdgcn_ds_swizzle((int)__float_as_uint(v), 0x401F));
    const auto rr = __builtin_amdgcn_permlane32_swap(__float_as_uint(v), __float_as_uint(v), false, false);
    return __uint_as_float(rr[0]) + __uint_as_float(rr[1]);
}
using pg8::Unit; using pg8::cvt_pk_bf16; using pg8::bf16_t;
typedef unsigned u32x4 __attribute__((ext_vector_type(4)));

__device__ __forceinline__ f32x4 dpp_shr1(const f32x4& v) {
    f32x4 o; float o0, o1, o2, o3;
    asm volatile("s_nop 1\n\tv_mov_b32_dpp %0, %4 row_shr:1 row_mask:0xf bank_mask:0xf bound_ctrl:1\n\tv_mov_b32_dpp %1, %5 row_shr:1 row_mask:0xf bank_mask:0xf bound_ctrl:1\n\t"
                 "v_mov_b32_dpp %2, %6 row_shr:1 row_mask:0xf bank_mask:0xf bound_ctrl:1\n\tv_mov_b32_dpp %3, %7 row_shr:1 row_mask:0xf bank_mask:0xf bound_ctrl:1"
                 : "=&v"(o0), "=&v"(o1), "=&v"(o2), "=&v"(o3) : "v"(v[0]), "v"(v[1]), "v"(v[2]), "v"(v[3]));
    o[0] = o0; o[1] = o1; o[2] = o2; o[3] = o3;
    return o;
}
struct EpiIn {
    static constexpr bool PERM = true, AFTER_DRAIN = false; static constexpr int PID = 1; static constexpr int MIDT = 0;
    unsigned char* wsb; float* out; const float *qn, *kn, *dtb, *cw, *cb;
    __device__ __forceinline__ void operator()(const f32x4 (&acc)[2][2][4][2], const Unit& u, int wr, int wc, int fr, int fq) const {
        bf16_t* const Q = (bf16_t*)(wsb + WS_Q); bf16_t* const Kb = (bf16_t*)(wsb + WS_K); bf16_t* const Vb = (bf16_t*)(wsb + WS_V); bf16_t* const ZS = (bf16_t*)(wsb + WS_ZS); bf16_t* const XBC = (bf16_t*)(wsb + WS_XBC);
        bf16_t* const GT = (bf16_t*)(wsb + WS_GT); bf16_t* const HALO = (bf16_t*)(wsb + WS_HALO); float* const DT = (float*)(wsb + WS_DT); const float* const rope = (const float*)(wsb + WS_ROPE);
        asm volatile("" : "+v"(fr), "+v"(fq));
        const int pn = u.pn;
        if (u.pm == 64 && wr == 1) return;
        const int rbase = u.pm * 256 + wr * 128 + fr * 8;
        if (pn <= 4) {
            const bool isq = pn < 4;
            const float* gw = isq ? qn : kn;
            f32x4 g[2][2];
#pragma unroll
            for (int bj = 0; bj < 2; ++bj)
#pragma unroll
                for (int n = 0; n < 2; ++n) g[bj][n] = *(const f32x4*)(gw + 32 * bj + 8 * fq + 4 * n);
            const float osc = isq ? 0.125f * 1.4426950408889634f : 1.0f;
            f32x4 rc[2], rs_[2], c1[2], s1[2];
            { const int tp0 = rbase < MP ? (rbase & (SEQ - 1)) : SEQ; const float* rp = rope + (size_t)tp0 * 64 + 8 * fq; const float* r1 = rope + 64 + 8 * fq;
              rc[0] = *(const f32x4*)rp; rc[1] = *(const f32x4*)(rp + 4); rs_[0] = *(const f32x4*)(rp + 32); rs_[1] = *(const f32x4*)(rp + 36);
              c1[0] = *(const f32x4*)r1; c1[1] = *(const f32x4*)(r1 + 4); s1[0] = *(const f32x4*)(r1 + 32); s1[1] = *(const f32x4*)(r1 + 36);
              if (rbase >= MP) { c1[0] = c1[1] = (f32x4){1.f, 1.f, 1.f, 1.f}; s1[0] = s1[1] = (f32x4){0.f, 0.f, 0.f, 0.f}; } }
#pragma unroll
            for (int idx = 0; idx < 8; ++idx) {
                const int ai = idx >> 2, m = idx & 3;
                const int r = rbase + idx;
                float ss = 0.f;
#pragma unroll
                for (int bj = 0; bj < 2; ++bj)
#pragma unroll
                    for (int n = 0; n < 2; ++n) { const f32x4 v = acc[ai][bj][m][n]; ss += (v[0] * v[0] + v[1] * v[1]) + (v[2] * v[2] + v[3] * v[3]); }
                ss = sum_fq(ss);
                const float rs = frsq_(ss * (1.0f / 64.0f) + EPS);
                f32x4 o1[2], o2[2];
#pragma unroll
                for (int n = 0; n < 2; ++n) {
                    const f32x4 x1 = acc[ai][0][m][n] * rs * g[0][n], x2 = acc[ai][1][m][n] * rs * g[1][n];
                    o1[n] = (x1 * rc[n] - x2 * rs_[n]) * osc; o2[n] = (x2 * rc[n] + x1 * rs_[n]) * osc;
                }
                u32x4 w1, w2;
                w1.x = cvt_pk_bf16(o1[0][0], o1[0][1]); w1.y = cvt_pk_bf16(o1[0][2], o1[0][3]); w1.z = cvt_pk_bf16(o1[1][0], o1[1][1]); w1.w = cvt_pk_bf16(o1[1][2], o1[1][3]);
                w2.x = cvt_pk_bf16(o2[0][0], o2[0][1]); w2.y = cvt_pk_bf16(o2[0][2], o2[0][3]); w2.z = cvt_pk_bf16(o2[1][0], o2[1][1]); w2.w = cvt_pk_bf16(o2[1][2], o2[1][3]);
                if (isq) {
                    bf16_t* dst = Q + (size_t)r * 1024 + (pn * 4 + wc) * 64 + 8 * fq;
                    *(u32x4*)dst = w1; *(u32x4*)(dst + 32) = w2;
                } else {
                    bf16_t* dst = Kb + (size_t)r * 256 + wc * 64 + 8 * fq;
                    *(u32x4*)dst = w1; *(u32x4*)(dst + 32) = w2;
                    float* fo = nullptr;
                    if (r >= MP) fo = out + O_KS + ((size_t)(r - MP) * 128 + 127) * 256;
                    else if ((r & (SEQ - 1)) >= SEQ - WIN) fo = out + O_KP + ((size_t)(r >> 11) * 128 + ((r & (SEQ - 1)) - (SEQ - WIN))) * 256;
                    if (fo) { fo += wc * 64 + 8 * fq; *(f32x4*)fo = o1[0]; *(f32x4*)(fo + 4) = o1[1]; *(f32x4*)(fo + 32) = o2[0]; *(f32x4*)(fo + 36) = o2[1]; }
                }
#pragma unroll
                for (int n = 0; n < 2; ++n) { const f32x4 cn = rc[n] * c1[n] - rs_[n] * s1[n], sn = rs_[n] * c1[n] + rc[n] * s1[n]; rc[n] = cn; rs_[n] = sn; }
            }
        } else if (pn == 34) {
            if (wc == 0) {
                f32x4 b0 = *(const f32x4*)(dtb + 8 * fq), b1 = *(const f32x4*)(dtb + 8 * fq + 4);
#pragma unroll
                for (int ai = 0; ai < 2; ++ai) {
#pragma unroll
                    for (int m = 0; m < 4; ++m) {
                        const int r = rbase + 4 * ai + m;
                        f32x4 v0 = acc[ai][0][m][0] + b0, v1 = acc[ai][0][m][1] + b1;
#pragma unroll
                        for (int e = 0; e < 4; ++e) { v0[e] = fmaxf(v0[e], 0.f) + 0.69314718056f * __builtin_amdgcn_logf(1.0f + __expf(-fabsf(v0[e]))); v1[e] = fmaxf(v1[e], 0.f) + 0.69314718056f * __builtin_amdgcn_logf(1.0f + __expf(-fabsf(v1[e]))); }
                        float* d = DT + (size_t)r * 32 + 8 * fq; *(f32x4*)d = v0; *(f32x4*)(d + 4) = v1;
                    }
                }
            }
        } else if (pn >= 14 && pn < 26) {
            const int cg0 = (pn - 14) * 256 + wc * 32 + 8 * fq;
            const bool dec = (u.pm == 64);
            if (dec) {
#pragma unroll
                for (int bj = 0; bj < 2; ++bj)
#pragma unroll
                    for (int ai = 0; ai < 2; ++ai)
#pragma unroll
                        for (int m = 0; m < 4; ++m) { float* f = out + O_CS + ((size_t)(rbase - MP + 4 * ai + m) * 3 + 2) * 3072 + cg0 + 128 * bj; *(f32x4*)f = acc[ai][bj][m][0]; *(f32x4*)(f + 4) = acc[ai][bj][m][1]; }
            } else {
                f32x4 wc_[4], bc_, wn_[4] = {}, bn_ = {};
                bc_ = *(const f32x4*)(cb + cg0);
#pragma unroll
                for (int j = 0; j < 4; ++j) wc_[j] = *(const f32x4*)(cw + j * 3072 + cg0);
                const int run = rbase >> 7, hent = (run >> 4) * 17 + 1 + (run & 15);
#pragma unroll
                for (int bj = 0; bj < 2; ++bj) {
                    const int cg = cg0 + 128 * bj;
                    if (fr == 0) {
#pragma unroll
                        for (int m = 0; m < 3; ++m) { u32x4 w; w.x = cvt_pk_bf16(acc[0][bj][m][0][0], acc[0][bj][m][0][1]); w.y = cvt_pk_bf16(acc[0][bj][m][0][2], acc[0][bj][m][0][3]); w.z = cvt_pk_bf16(acc[0][bj][m][1][0], acc[0][bj][m][1][1]); w.w = cvt_pk_bf16(acc[0][bj][m][1][2], acc[0][bj][m][1][3]);
                            *(u32x4*)(HALO + ((size_t)hent * 6 + m) * 3072 + cg) = w; }
                    }
                    if (fr == 15) {
#pragma unroll
                        for (int m = 1; m < 4; ++m) { u32x4 w; w.x = cvt_pk_bf16(acc[1][bj][m][0][0], acc[1][bj][m][0][1]); w.y = cvt_pk_bf16(acc[1][bj][m][0][2], acc[1][bj][m][0][3]); w.z = cvt_pk_bf16(acc[1][bj][m][1][0], acc[1][bj][m][1][1]); w.w = cvt_pk_bf16(acc[1][bj][m][1][2], acc[1][bj][m][1][3]);
                            *(u32x4*)(HALO + ((size_t)hent * 6 + 2 + m) * 3072 + cg) = w;
                            if ((run & 15) == 15) { float* f = out + O_CP + ((size_t)(run >> 4) * 3 + (m - 1)) * 3072 + cg; *(f32x4*)f = acc[1][bj][m][0]; *(f32x4*)(f + 4) = acc[1][bj][m][1]; } }
                    }
                }
                const size_t xr0 = (size_t)((rbase >> 11) * XROWS + 8 + (rbase & (SEQ - 1)));
                typedef unsigned u32x2e __attribute__((ext_vector_type(2)));
                u32x2e keep[8];
#pragma unroll
                for (int st = 0; st < 4; ++st) {
                    const int bj = st >> 1, n = st & 1, cg = cg0 + 128 * bj;
                    if (st < 3) { const int cn = cg0 + 128 * ((st + 1) >> 1) + 4 * ((st + 1) & 1); bn_ = *(const f32x4*)(cb + cn);
#pragma unroll
                        for (int j = 0; j < 4; ++j) wn_[j] = *(const f32x4*)(cw + j * 3072 + cn); }
                    const f32x4 h3 = dpp_shr1(acc[1][bj][1][n]), h2 = dpp_shr1(acc[1][bj][2][n]), h1 = dpp_shr1(acc[1][bj][3][n]);
#pragma unroll
                    for (int idx = 0; idx < 8; ++idx) {
                        const f32x4 v0 = acc[idx >> 2][bj][idx & 3][n];
                        const f32x4 v1 = idx >= 1 ? acc[(idx - 1) >> 2][bj][(idx - 1) & 3][n] : h1;
                        const f32x4 v2 = idx >= 2 ? acc[(idx - 2) >> 2][bj][(idx - 2) & 3][n] : (idx == 1 ? h1 : h2);
                        const f32x4 v3 = idx >= 3 ? acc[(idx - 3) >> 2][bj][(idx - 3) & 3][n] : (idx == 2 ? h1 : (idx == 1 ? h2 : h3));
                        f32x4 x = bc_ + wc_[3] * v0 + wc_[2] * v1 + wc_[1] * v2 + wc_[0] * v3;
                        x = silu4_(x);
                        u32x2e w; w.x = cvt_pk_bf16(x[0], x[1]); w.y = cvt_pk_bf16(x[2], x[3]);
                        if (n == 0) keep[idx] = w; else { const u32x4 w4 = {keep[idx].x, keep[idx].y, w.x, w.y}; *(u32x4*)(XBC + (xr0 + idx) * 3072 + cg) = w4; }
                    }
                    bc_ = bn_;
#pragma unroll
                    for (int j = 0; j < 4; ++j) wc_[j] = wn_[j];
                }
            }
        } else {
            const int kind = pn == 5 ? 0 : (pn < 14 ? 1 : 3);
            bf16_t* base; int ld, c0;
            if (kind == 0) { base = Vb; ld = 256; c0 = 0; } else if (kind == 1) { base = ZS; ld = 2048; c0 = (pn - 6) * 256; } else { base = GT; ld = 2048; c0 = (pn - 26) * 256; }
            c0 += wc * 32 + 8 * fq;
#pragma unroll
            for (int ai = 0; ai < 2; ++ai) {
#pragma unroll
                for (int m = 0; m < 4; ++m) {
                    const int r = rbase + 4 * ai + m;
                    float* fo = nullptr;
                    if (kind == 0) {
                        if (r >= MP) fo = out + O_VS + ((size_t)(r - MP) * 128 + 127) * 256;
                        else if ((r & (SEQ - 1)) >= SEQ - WIN) fo = out + O_VP + ((size_t)(r >> 11) * 128 + ((r & (SEQ - 1)) - (SEQ - WIN))) * 256;
                    }
#pragma unroll
                    for (int bj = 0; bj < 2; ++bj) {
                        f32x4 v0 = acc[ai][bj][m][0], v1 = acc[ai][bj][m][1];
                        if (fo) { float* f = fo + c0 + 128 * bj; *(f32x4*)f = v0; *(f32x4*)(f + 4) = v1; }
                        if (kind == 1) {
                            v0 = silu4_(v0); v1 = silu4_(v1);
                        } else if (kind == 3) {
                            v0 = sigmoid4_(v0); v1 = sigmoid4_(v1);
                        }
                        u32x4 w; w.x = cvt_pk_bf16(v0[0], v0[1]); w.y = cvt_pk_bf16(v0[2], v0[3]); w.z = cvt_pk_bf16(v1[0], v1[1]); w.w = cvt_pk_bf16(v1[2], v1[3]);
                        *(u32x4*)(base + (size_t)r * ld + c0 + 128 * bj) = w;
                    }
                }
            }
        }
    }
};

struct EpiMixF {
    static constexpr bool PERM = true, AFTER_DRAIN = false; static constexpr int PID = 3; static constexpr int MIDT = 16;
    const bf16_t* GT; const float* SSQ2; bf16_t* MIX;
    __device__ __forceinline__ float row_r2(int r, int fq) const {
        float ss = 0.f;
#pragma unroll
        for (int j = 0; j < 4; ++j) { const f32x4 p = *(const f32x4*)(SSQ2 + (size_t)r * 64 + 16 * fq + 4 * j); ss += (p[0] + p[1]) + (p[2] + p[3]); }
        ss = sum_fq(ss);
        return frsq_(ss * (1.0f / 2048.0f) + EPS);
    }
    __device__ __forceinline__ void mid(f32x4 (&acc)[2][2][4][2], const Unit& u, int wr, int wc, int fr, int fq) const {
        asm volatile("" : "+v"(fr), "+v"(fq));
#pragma unroll
        for (int ai = 0; ai < 2; ++ai)
#pragma unroll
            for (int m = 0; m < 4; ++m) {
                const int r = u.pm * 256 + ai * 128 + wr * 64 + m * 16 + fr;
                const float ir2 = frcp_(row_r2(r, fq));
#pragma unroll
                for (int bj = 0; bj < 2; ++bj) {
                    const int c = u.pn * 256 + 128 * bj + wc * 32 + 8 * fq;
                    const u32x4 ga = *(const u32x4*)(GT + (size_t)r * 2048 + c), gs = *(const u32x4*)(GT + (size_t)r * 2048 + 1024 + c);
                    f32x4& v0 = acc[ai][bj][m][0]; f32x4& v1 = acc[ai][bj][m][1];
                    v0[0] *= bflo(ga.x) * ir2 * frcp_(bflo(gs.x)); v0[1] *= bfhi(ga.x) * ir2 * frcp_(bfhi(gs.x)); v0[2] *= bflo(ga.y) * ir2 * frcp_(bflo(gs.y)); v0[3] *= bfhi(ga.y) * ir2 * frcp_(bfhi(gs.y));
                    v1[0] *= bflo(ga.z) * ir2 * frcp_(bflo(gs.z)); v1[1] *= bfhi(ga.z) * ir2 * frcp_(bfhi(gs.z)); v1[2] *= bflo(ga.w) * ir2 * frcp_(bflo(gs.w)); v1[3] *= bfhi(ga.w) * ir2 * frcp_(bfhi(gs.w));
                }
            }
    }
    __device__ __forceinline__ void operator()(const f32x4 (&acc)[2][2][4][2], const Unit& u, int wr, int wc, int fr, int fq) const {
        asm volatile("" : "+v"(fr), "+v"(fq));
#pragma unroll
        for (int ai = 0; ai < 2; ++ai)
#pragma unroll
            for (int m = 0; m < 4; ++m) {
                const int r = u.pm * 256 + ai * 128 + wr * 64 + m * 16 + fr;
                const float r2 = row_r2(r, fq);
#pragma unroll
                for (int bj = 0; bj < 2; ++bj) {
                    const int c = u.pn * 256 + 128 * bj + wc * 32 + 8 * fq;
                    const u32x4 gs = *(const u32x4*)(GT + (size_t)r * 2048 + 1024 + c);
                    const f32x4 v0 = acc[ai][bj][m][0] * r2, v1 = acc[ai][bj][m][1] * r2;
                    u32x4 w; w.x = cvt_pk_bf16(v0[0] * bflo(gs.x), v0[1] * bfhi(gs.x)); w.y = cvt_pk_bf16(v0[2] * bflo(gs.y), v0[3] * bfhi(gs.y)); w.z = cvt_pk_bf16(v1[0] * bflo(gs.z), v1[1] * bfhi(gs.z)); w.w = cvt_pk_bf16(v1[2] * bflo(gs.w), v1[3] * bfhi(gs.w));
                    *(u32x4*)(MIX + (size_t)r * 1024 + c) = w;
                }
            }
    }
};
struct EpiRes1 {
    static constexpr bool PERM = true, AFTER_DRAIN = false; static constexpr int PID = 4; static constexpr int MIDT = 0;
    const float* xp; const float* xs; float* out; bf16_t* X1B; float* SSQ3;
    __device__ __forceinline__ void operator()(const f32x4 (&acc)[2][2][4][2], const Unit& u, int wr, int wc, int fr, int fq) const {
        asm volatile("" : "+v"(fr), "+v"(fq));
        const int c0 = u.pn * 256 + wc * 32 + 8 * fq;
        f32x4 xa, xb, na = {}, nb = {};
        { const int r = u.pm * 256 + wr * 64 + fr; const float* xr = (r < MP ? xp + (size_t)r * 1024 : xs + (size_t)(r - MP) * 1024) + c0; xa = *(const f32x4*)xr; xb = *(const f32x4*)(xr + 4); }
        float ss = 0.f;
#pragma unroll
        for (int st = 0; st < 16; ++st) {
            const int ai = st >> 3, m = (st >> 1) & 3, bj = st & 1;
            const int r = u.pm * 256 + ai * 128 + wr * 64 + m * 16 + fr, c = c0 + 128 * bj;
            if (st < 15) { const int s2 = st + 1, r2 = u.pm * 256 + (s2 >> 3) * 128 + wr * 64 + ((s2 >> 1) & 3) * 16 + fr;
                const float* xr = (r2 < MP ? xp + (size_t)r2 * 1024 : xs + (size_t)(r2 - MP) * 1024) + c0 + 128 * (s2 & 1); na = *(const f32x4*)xr; nb = *(const f32x4*)(xr + 4); }
            const f32x4 v0 = acc[ai][bj][m][0] + xa, v1 = acc[ai][bj][m][1] + xb;
            ss += (v0[0] * v0[0] + v0[1] * v0[1]) + (v0[2] * v0[2] + v0[3] * v0[3]) + (v1[0] * v1[0] + v1[1] * v1[1]) + (v1[2] * v1[2] + v1[3] * v1[3]);
            u32x4 w; w.x = cvt_pk_bf16(v0[0], v0[1]); w.y = cvt_pk_bf16(v0[2], v0[3]); w.z = cvt_pk_bf16(v1[0], v1[1]); w.w = cvt_pk_bf16(v1[2], v1[3]);
            *(u32x4*)(X1B + (size_t)r * 1024 + c) = w;
            if (bj == 1) { ss = sum_fq(ss); if (fq == 0) SSQ3[(size_t)r * 16 + u.pn * 4 + wc] = ss; ss = 0.f; }
            xa = na; xb = nb;
        }
    }
};
struct EpiUp {
    static constexpr bool PERM = true, AFTER_DRAIN = false; static constexpr int PID = 5; static constexpr int MIDT = 0;
    const float* SSQ3; bf16_t* ACT;
    __device__ __forceinline__ void operator()(const f32x4 (&acc)[2][2][4][2], const Unit& u, int wr, int wc, int fr, int fq) const {
        asm volatile("" : "+v"(fr), "+v"(fq));
        f32x4 pp[2][4];
#pragma unroll
        for (int ai = 0; ai < 2; ++ai)
#pragma unroll
            for (int m = 0; m < 4; ++m) pp[ai][m] = *(const f32x4*)(SSQ3 + (size_t)(u.pm * 256 + ai * 128 + wr * 64 + m * 16 + fr) * 16 + 4 * fq);
#pragma unroll
        for (int ai = 0; ai < 2; ++ai)
#pragma unroll
            for (int m = 0; m < 4; ++m) {
                const int r = u.pm * 256 + ai * 128 + wr * 64 + m * 16 + fr;
                const f32x4 p = pp[ai][m];
                float ss = (p[0] + p[1]) + (p[2] + p[3]);
                ss = sum_fq(ss);
                const float r3 = frsq_(ss * (1.0f / 1024.0f) + EPS);
#pragma unroll
                for (int bj = 0; bj < 2; ++bj) {
                    const int c = u.pn * 256 + 128 * bj + wc * 32 + 8 * fq;
                    f32x4 v0 = acc[ai][bj][m][0] * r3, v1 = acc[ai][bj][m][1] * r3;
#pragma unroll
                    for (int e = 0; e < 4; ++e) { v0[e] = fmaxf(v0[e], 0.f); v0[e] *= v0[e]; v1[e] = fmaxf(v1[e], 0.f); v1[e] *= v1[e]; }
                    u32x4 w; w.x = cvt_pk_bf16(v0[0], v0[1]); w.y = cvt_pk_bf16(v0[2], v0[3]); w.z = cvt_pk_bf16(v1[0], v1[1]); w.w = cvt_pk_bf16(v1[2], v1[3]);
                    *(u32x4*)(ACT + (size_t)r * 4096 + c) = w;
                }
            }
    }
};
struct EpiDown {
    static constexpr bool PERM = true, AFTER_DRAIN = false; static constexpr int PID = 6; static constexpr int MIDT = 0;
    const bf16_t* X1B; float* out;
    __device__ __forceinline__ void operator()(const f32x4 (&acc)[2][2][4][2], const Unit& u, int wr, int wc, int fr, int fq) const {
        asm volatile("" : "+v"(fr), "+v"(fq));
        const int c0 = u.pn * 256 + wc * 32 + 8 * fq;
        u32x4 xw = *(const u32x4*)(X1B + (size_t)(u.pm * 256 + wr * 64 + fr) * 1024 + c0), xn = {};
#pragma unroll
        for (int st = 0; st < 16; ++st) {
            const int ai = st >> 3, m = (st >> 1) & 3, bj = st & 1;
            const int r = u.pm * 256 + ai * 128 + wr * 64 + m * 16 + fr, c = c0 + 128 * bj;
            if (st < 15) { const int s2 = st + 1; xn = *(const u32x4*)(X1B + (size_t)(u.pm * 256 + (s2 >> 3) * 128 + wr * 64 + ((s2 >> 1) & 3) * 16 + fr) * 1024 + c0 + 128 * (s2 & 1)); }
            f32x4 v0 = acc[ai][bj][m][0], v1 = acc[ai][bj][m][1];
            v0[0] += bflo(xw.x); v0[1] += bfhi(xw.x); v0[2] += bflo(xw.y); v0[3] += bfhi(xw.y); v1[0] += bflo(xw.z); v1[1] += bfhi(xw.z); v1[2] += bflo(xw.w); v1[3] += bfhi(xw.w);
            float* d = out + (size_t)r * 1024 + c; *(f32x4*)d = v0; *(f32x4*)(d + 4) = v1;
            xw = xn;
        }
    }
};

struct Args { const float* in[23]; float* out; unsigned char* ws; double invf[32]; int ph_lo, ph_hi; };
enum { I_XP = 0, I_XS, I_CK, I_CV, I_SC, I_SS, I_NMIX, I_WIN, I_QN, I_KN, I_SINK, I_CW, I_CB, I_DTB, I_ALOG, I_DSK, I_SNORM, I_WAO, I_WSO, I_WOUT, I_NMLP, I_WUP, I_WDN };

struct Frame {
    LAS unsigned char* lds;
    int wave, vcu, G;
};

__device__ __forceinline__ float wave_sum(float v) {
#pragma unroll
    for (int o = 1; o < 64; o <<= 1) v += __shfl_xor(v, o);
    return v;
}
__device__ __forceinline__ float wave_max(float v) {
#pragma unroll
    for (int o = 1; o < 64; o <<= 1) v = fmaxf(v, __shfl_xor(v, o));
    return v;
}

struct P0Item { const float* W; const float* gain; bf16* WT; int K, N, prow0, k0, n0; };
__device__ __forceinline__ void p0_item_load(const P0Item& t, f32x4 (&v)[8], float (&gk)[8], int lane) {
#pragma unroll
    for (int i = 0; i < 8; ++i) { const int kk = (lane >> 3) + 8 * i; v[i] = *(const f32x4*)(t.W + (size_t)(t.k0 + kk) * t.N + t.n0 + 4 * (lane & 7)); gk[i] = t.gain ? t.gain[t.k0 + kk] : 1.0f; }
}
__device__ __forceinline__ void p0_item_finish(const P0Item& t, const f32x4 (&v)[8], const float (&gk)[8], LAS float* scr, int lane) {
#pragma unroll
    for (int i = 0; i < 8; ++i) { const int kk = (lane >> 3) + 8 * i; LAS float* d = scr + kk * 33 + 4 * (lane & 7); d[0] = v[i][0] * gk[i]; d[1] = v[i][1] * gk[i]; d[2] = v[i][2] * gk[i]; d[3] = v[i][3] * gk[i]; }
    LDS_WAIT(); asm volatile("" ::: "memory");
    const int c = lane & 7;
#pragma unroll
    for (int j = 0; j < 4; ++j) { const int n = (lane >> 3) + 8 * j; const LAS float* s = scr + (8 * c) * 33 + n;
        v4u o; o.x = pk2(s[0 * 33], s[1 * 33]); o.y = pk2(s[2 * 33], s[3 * 33]); o.z = pk2(s[4 * 33], s[5 * 33]); o.w = pk2(s[6 * 33], s[7 * 33]);
        *(GAS v4u*)(t.WT + (size_t)(t.prow0 + n) * t.K + t.k0 + 8 * c) = o; }
    LDS_WAIT(); asm volatile("" ::: "memory");
}
__device__ __forceinline__ int win_phys_row(int n0) {
    if (n0 < 1280) { const int tile = n0 >> 8, within = n0 & 255, hh = within >> 6, half = (within & 63) >> 5; return tile * 256 + 128 * half + 32 * hh; }
    if (n0 < 6656) return n0;
    if (n0 < 6688) return 8704 + (n0 - 6656);
    return n0 - 32;
}

__device__ __forceinline__ void p0_prologue(Frame& F0, const Args& a) {
    struct { LAS unsigned char* lds; int tid, lane, wave, vcu, G; } F;
    F.lds = F0.lds; F.wave = F0.wave; F.vcu = F0.vcu; F.G = F0.G; F.lane = (int)__builtin_amdgcn_mbcnt_hi(~0u, __builtin_amdgcn_mbcnt_lo(~0u, 0u)); F.tid = F.wave * 64 + F.lane;
    unsigned char* ws = a.ws;
    LAS float* scr = (LAS float*)(F.lds + RING_OFF + F.wave * 16384);
    const int gw = F.vcu * NWAVES + F.wave, NGW = F.G * NWAVES;
    constexpr int I_1 = 16 * 273, I_A = 16 * 32, I_S = 32 * 32, I_O = 16 * 32, I_U = 16 * 128, I_D = 64 * 32;
    constexpr int NITEMS = I_1 + I_A + I_S + I_O + I_U + I_D;
    auto decode = [&](int it, P0Item& t) {
        int r = it;
        if (r < I_1) { const int kb = r / 273, nb = r % 273; t = P0Item{a.in[I_WIN], a.in[I_NMIX], (bf16*)(ws + WS_WT1), 1024, 8736, win_phys_row(nb * 32), kb * 64, nb * 32}; return; } r -= I_1;
        if (r < I_A) { const int kb = r / 32, nb = r % 32; t = P0Item{a.in[I_WAO], nullptr, (bf16*)(ws + WS_WTA), 3072, 1024, nb * 32, kb * 64, nb * 32}; return; } r -= I_A;
        if (r < I_S) { const int kb = r / 32, nb = r % 32; t = P0Item{a.in[I_WSO], a.in[I_SNORM], (bf16*)(ws + WS_WTA) + 1024, 3072, 1024, nb * 32, kb * 64, nb * 32}; return; } r -= I_S;
        if (r < I_O) { const int kb = r / 32, nb = r % 32; t = P0Item{a.in[I_WOUT], nullptr, (bf16*)(ws + WS_WTO), 1024, 1024, nb * 32, kb * 64, nb * 32}; return; } r -= I_O;
        if (r < I_U) { const int kb = r / 128, nb = r % 128; t = P0Item{a.in[I_WUP], a.in[I_NMLP], (bf16*)(ws + WS_WTU), 1024, 4096, nb * 32, kb * 64, nb * 32}; return; } r -= I_U;
        { const int kb = r / 32, nb = r % 32; t = P0Item{a.in[I_WDN], nullptr, (bf16*)(ws + WS_WTD), 4096, 1024, nb * 32, kb * 64, nb * 32}; }
    };
    P_BEGIN(31, F.lds, F.wave);
    for (int it = gw; it < NITEMS; it += 2 * NGW) {
        P0Item t0, t1; f32x4 v0[8], v1[8]; float g0[8], g1[8];
        const bool two = it + NGW < NITEMS;
        decode(it, t0); decode(two ? it + NGW : it, t1);
        p0_item_load(t0, v0, g0, F.lane); p0_item_load(t1, v1, g1, F.lane);
        p0_item_finish(t0, v0, g0, scr, F.lane);
        if (two) p0_item_finish(t1, v1, g1, scr, F.lane);
    }
    P_END(31, F.lds, F.wave); P_BEGIN(32, F.lds, F.wave);
    bf16* XB = (bf16*)(ws + WS_XB);
    for (int m0 = 4 * gw; m0 < MPAD; m0 += 4 * NGW) {
        f32x4 v[4][4];
#pragma unroll
        for (int q = 0; q < 4; ++q) {
            const int m = m0 + q, mc = m < MTOK ? m : 0;
            const float* xrow = mc < MP ? a.in[I_XP] + (size_t)mc * 1024 : a.in[I_XS] + (size_t)(mc - MP) * 1024;
            const GAS f32x4* xr = (const GAS f32x4*)xrow + F.lane;
#pragma unroll
            for (int j = 0; j < 4; ++j) v[q][j] = xr[64 * j];
        }
#pragma unroll
        for (int q = 0; q < 4; ++q) {
            const int m = m0 + q;
            float s = 0.f;
#pragma unroll
            for (int j = 0; j < 4; ++j) s += (v[q][j].x * v[q][j].x + v[q][j].y * v[q][j].y) + (v[q][j].z * v[q][j].z + v[q][j].w * v[q][j].w);
            const float rstd = m < MTOK ? frsq_(wave_sum(s) * (1.f / 1024.f) + EPS) : 0.f;
            if (m < MPAD) {
                GAS unsigned long long* o8 = (GAS unsigned long long*)(XB + (size_t)m * 1024) + F.lane;
#pragma unroll
                for (int j = 0; j < 4; ++j) o8[64 * j] = (unsigned long long)pk2(v[q][j].x * rstd, v[q][j].y * rstd) | ((unsigned long long)pk2(v[q][j].z * rstd, v[q][j].w * rstd) << 32);
            }
        }
    }
    P_END(32, F.lds, F.wave); P_BEGIN(33, F.lds, F.wave);
    const int gt = F.vcu * (NWAVES * 64) + F.tid, NGT = F.G * NWAVES * 64;
    float* rope = (float*)(ws + WS_ROPE);
    for (int e = gt; e < 2049 * 32; e += NGT) {
        const int t = e >> 5, i = e & 31;
        const double ang = (double)(t == 2048 ? 8192 : t) * a.invf[i];
        const double q = rint(ang * 0.63661977236758134308);
        double rr = fma(-q, 1.57079632679489655800, ang); rr = fma(-q, 6.12323399573676603587e-17, rr);
        const double r2 = rr * rr;
        const double sn = rr * (1.0 + r2 * (-1.0 / 6 + r2 * (1.0 / 120 + r2 * (-1.0 / 5040 + r2 * (1.0 / 362880 + r2 * (-1.0 / 39916800 + r2 * (1.0 / 6227020800.0)))))));
        const double cs = 1.0 + r2 * (-0.5 + r2 * (1.0 / 24 + r2 * (-1.0 / 720 + r2 * (1.0 / 40320 + r2 * (-1.0 / 3628800 + r2 * (1.0 / 479001600 + r2 * (-1.0 / 87178291200.0)))))));
        const int qi = ((int)q) & 3;
        const double s = (qi == 0) ? sn : (qi == 1) ? cs : (qi == 2) ? -sn : -cs;
        const double c = (qi == 0) ? cs : (qi == 1) ? -sn : (qi == 2) ? -cs : sn;
        rope[(size_t)t * 64 + i] = (float)c; rope[(size_t)t * 64 + 32 + i] = (float)s;
    }
    P_END(33, F.lds, F.wave); P_BEGIN(34, F.lds, F.wave);
    { u32x4* xz = (u32x4*)(ws + WS_XBC); for (int e = gt; e < NB * 8 * 384; e += NGT) { const int bb = e / (8 * 384), rem = e % (8 * 384); xz[(size_t)bb * XROWS * 384 + rem] = (u32x4){0u, 0u, 0u, 0u}; } }
    { u32x4* hz = (u32x4*)(ws + WS_HALO); for (int e = gt; e < NB * 6 * 384; e += NGT) { const int bb = e / (6 * 384), rem = e % (6 * 384); hz[(size_t)bb * 17 * 6 * 384 + rem] = (u32x4){0u, 0u, 0u, 0u}; } }
    {
        const f32x4* sc = (const f32x4*)a.in[I_SC]; f32x4* cs = (f32x4*)(a.out + O_CS);
        for (int e = gt; e < 128 * 2 * 768; e += NGT) { const int b = e / (2 * 768), rem = e % (2 * 768); cs[(size_t)b * 3 * 768 + rem] = sc[(size_t)b * 3 * 768 + 768 + rem]; }
    }    P_END(34, F.lds, F.wave);
}

template <bool DECODE>
__device__ __forceinline__ void attn_simple(Frame& F, const Args& a) {
    unsigned char* ws = a.ws;
    const bf16* Q = (const bf16*)(ws + WS_Q); const bf16* Kb = (const bf16*)(ws + WS_K); const bf16* Vb = (const bf16*)(ws + WS_V); bf16* OA = (bf16*)(ws + WS_OA);
    const float* sinks = a.in[I_SINK];
    int tid_ = F.wave * 64 + (int)__builtin_amdgcn_mbcnt_hi(~0u, __builtin_amdgcn_mbcnt_lo(~0u, 0u)); asm volatile("" : "+v"(tid_));
    const int lane = tid_ & 63, gw = F.vcu * NWAVES + __builtin_amdgcn_readfirstlane(tid_ >> 6), NGW = F.G * NWAVES;
    const int ntask = (DECODE ? DEC : MP) * NH;
    for (int task = gw; task < ntask; task += NGW) {
        const int rr = task >> 4, h = task & 15, kvh = h >> 2;
        const int r = DECODE ? MP + rr : rr;
        u32x4 qw[8];
        {
            const u32x4* qp = (const u32x4*)(Q + (size_t)r * 1024 + h * 64);
#pragma unroll
            for (int c = 0; c < 8; ++c) qw[c] = qp[c];
        }
#define QV(i_) (((i_) & 1) ? bfhi(qw[(i_) >> 3][((i_) >> 1) & 3]) : bflo(qw[(i_) >> 3][((i_) >> 1) & 3]))
        float sA, sB;
        if (DECODE) {
            const float* ckb = a.in[I_CK] + (size_t)rr * 128 * 256 + kvh * 64; float* ksb = a.out + O_KS + (size_t)rr * 128 * 256 + kvh * 64;
            float s0 = 0.f, s1 = 0.f;
            const f32x4* k0 = (const f32x4*)(ckb + (size_t)(lane + 1) * 256); const f32x4* k1 = (const f32x4*)(lane < 63 ? ckb + (size_t)(lane + 65) * 256 : ksb + (size_t)127 * 256);
            const bool cpk = (h & 3) == 0;
            f32x4 kx[16], ky[16];
#pragma unroll
            for (int c = 0; c < 16; ++c) { kx[c] = k0[c]; ky[c] = k1[c]; }
#pragma unroll
            for (int c = 0; c < 16; ++c) { const f32x4 x = kx[c], y = ky[c]; const float q0 = QV(4 * c), q1 = QV(4 * c + 1), q2 = QV(4 * c + 2), q3 = QV(4 * c + 3);
                s0 += q0 * x[0] + q1 * x[1] + q2 * x[2] + q3 * x[3]; s1 += q0 * y[0] + q1 * y[1] + q2 * y[2] + q3 * y[3]; }
            if (cpk) { f32x4* d0 = (f32x4*)(ksb + (size_t)lane * 256); f32x4* d1 = (f32x4*)(ksb + (size_t)(lane + 64) * 256);
#pragma unroll
                for (int c = 0; c < 16; ++c) { d0[c] = kx[c]; d1[c] = ky[c]; } }
            sA = s0; sB = s1;
        } else {
            const int b = r >> 11, t = r & (SEQ - 1);
            const int kA = t - 127 + lane, kB = t - 63 + lane;
            const int rA = b * SEQ + (kA < 0 ? 0 : kA), rB = b * SEQ + (kB < 0 ? 0 : kB);
            const u32x4* pA = (const u32x4*)(Kb + (size_t)rA * 256 + kvh * 64); const u32x4* pB = (const u32x4*)(Kb + (size_t)rB * 256 + kvh * 64);
            float s0 = 0.f, s1 = 0.f;
#pragma unroll
            for (int c = 0; c < 8; ++c) { const u32x4 x = pA[c], y = pB[c];
                s0 += QV(8 * c) * bflo(x.x) + QV(8 * c + 1) * bfhi(x.x) + QV(8 * c + 2) * bflo(x.y) + QV(8 * c + 3) * bfhi(x.y) + QV(8 * c + 4) * bflo(x.z) + QV(8 * c + 5) * bfhi(x.z) + QV(8 * c + 6) * bflo(x.w) + QV(8 * c + 7) * bfhi(x.w);
                s1 += QV(8 * c) * bflo(y.x) + QV(8 * c + 1) * bfhi(y.x) + QV(8 * c + 2) * bflo(y.y) + QV(8 * c + 3) * bfhi(y.y) + QV(8 * c + 4) * bflo(y.z) + QV(8 * c + 5) * bfhi(y.z) + QV(8 * c + 6) * bflo(y.w) + QV(8 * c + 7) * bfhi(y.w); }
            sA = kA < 0 ? -INFINITY : s0; sB = kB < 0 ? -INFINITY : s1;
        }
        const float sink = sinks[h] * 1.4426950408889634f;
        const float mx = fmaxf(wave_max(fmaxf(sA, sB)), sink);
        float pA_ = __builtin_amdgcn_exp2f(sA - mx), pB_ = __builtin_amdgcn_exp2f(sB - mx);
        const float den = wave_sum(pA_ + pB_) + __builtin_amdgcn_exp2f(sink - mx);
        const float inv = frcp_(den); pA_ *= inv; pB_ *= inv;
        float o = 0.f;
        if (DECODE) {
            const float* cvb = a.in[I_CV] + (size_t)rr * 128 * 256 + kvh * 64 + lane; float* vsb = a.out + O_VS + (size_t)rr * 128 * 256 + kvh * 64 + lane;
            const bool cpv = (h & 3) == 0;
            float va[64], vb[64];
#pragma unroll
            for (int j = 0; j < 64; ++j) { va[j] = cvb[(size_t)(j + 1) * 256]; vb[j] = j < 63 ? cvb[(size_t)(j + 65) * 256] : vsb[(size_t)127 * 256]; }
#pragma unroll
            for (int j = 0; j < 64; ++j) { const float pa = __int_as_float(__builtin_amdgcn_readlane(__float_as_int(pA_), j)), pb = __int_as_float(__builtin_amdgcn_readlane(__float_as_int(pB_), j)); o += pa * va[j] + pb * vb[j]; }
            if (cpv) {
#pragma unroll
                for (int j = 0; j < 64; ++j) { vsb[(size_t)j * 256] = va[j]; vsb[(size_t)(j + 64) * 256] = vb[j]; }
            }
        } else {
            const int b = r >> 11, t = r & (SEQ - 1);
            for (int j = 0; j < 64; ++j) { const float pa = __shfl(pA_, j), pb = __shfl(pB_, j);
                const int kA = t - 127 + j, kB = t - 63 + j; const int rA = b * SEQ + (kA < 0 ? 0 : kA), rB = b * SEQ + (kB < 0 ? 0 : kB);
                o += pa * bf2f(Vb[(size_t)rA * 256 + kvh * 64 + lane]) + pb * bf2f(Vb[(size_t)rB * 256 + kvh * 64 + lane]); }
        }
        OA[(size_t)r * 3072 + h * 64 + lane] = (bf16)f2bf(o);
    }
}

__device__ __forceinline__ void ssd_simple_prompt(Frame& F, const Args& a) {
    unsigned char* ws = a.ws;
    const bf16* XBC = (const bf16*)(ws + WS_XBC); const bf16* ZS = (const bf16*)(ws + WS_ZS); const float* DT = (const float*)(ws + WS_DT);
    bf16* YZ = (bf16*)(ws + WS_YZ); float* SSQ2 = (float*)(ws + WS_SSQ2);
    const float* cw = a.in[I_CW]; const float* cb = a.in[I_CB];
    LAS float* xs = (LAS float*)(F.lds);
    LAS float* Bs = xs + 64 * 64;
    LAS float* Cs = Bs + 64 * 128;
    LAS float* zs = Cs + 64 * 128;
    LAS float* ys = zs + 64 * 64;
    LAS float* dts = ys + 64 * 64;
    const int tid = F.wave * 64 + (int)__builtin_amdgcn_mbcnt_hi(~0u, __builtin_amdgcn_mbcnt_lo(~0u, 0u)), p = tid >> 3, nq = tid & 7;
    for (int item = F.vcu; item < NB * SH; item += F.G) {
        const int b = item >> 5, hh = item & 31, g = hh >> 3;
        const float A = -__expf(a.in[I_ALOG][hh]), Dk = a.in[I_DSK][hh];
        float h[16];
#pragma unroll
        for (int i = 0; i < 16; ++i) h[i] = 0.f;
        for (int t0 = 0; t0 < SEQ; t0 += 64) {
            for (int e = tid; e < 64 * 320; e += 512) {
                const int tok = e / 320, ch = e % 320;
                const int gch = ch < 64 ? hh * 64 + ch : (ch < 192 ? 2048 + g * 128 + (ch - 64) : 2560 + g * 128 + (ch - 192));
                float acc = cb[gch];
#pragma unroll
                for (int j = 0; j < 4; ++j) { const int tt = t0 + tok - 3 + j; if (tt >= 0) acc += cw[j * 3072 + gch] * bf2f(XBC[(size_t)(b * XROWS + 8 + tt) * 3072 + gch]); }
                const float v = siluf_(acc);
                if (ch < 64) xs[tok * 64 + ch] = v; else if (ch < 192) Bs[tok * 128 + ch - 64] = v; else Cs[tok * 128 + ch - 192] = v;
            }
            for (int e = tid; e < 64 * 64; e += 512) { const int tok = e >> 6, pp = e & 63; zs[e] = bf2f(ZS[(size_t)(b * SEQ + t0 + tok) * 2048 + hh * 64 + pp]); }
            if (tid < 64) dts[tid] = DT[(size_t)(b * SEQ + t0 + tid) * 32 + hh];
            __syncthreads();
            for (int tok = 0; tok < 64; ++tok) {
                const float dt = dts[tok], dA = __expf(dt * A), x = xs[tok * 64 + p], dx = dt * x;
                float y = 0.f;
#pragma unroll
                for (int i4 = 0; i4 < 4; ++i4) {
                    const f32x4 bv = *(const LAS f32x4*)(Bs + tok * 128 + nq * 16 + 4 * i4), cv = *(const LAS f32x4*)(Cs + tok * 128 + nq * 16 + 4 * i4);
#pragma unroll
                    for (int e = 0; e < 4; ++e) { h[4 * i4 + e] = dA * h[4 * i4 + e] + dx * bv[e]; y += h[4 * i4 + e] * cv[e]; }
                }
                y += __shfl_xor(y, 1); y += __shfl_xor(y, 2); y += __shfl_xor(y, 4);
                if (nq == 0) ys[tok * 64 + p] = (y + Dk * x) * zs[tok * 64 + p];
            }
            __syncthreads();
            for (int e = tid; e < 64 * 64; e += 512) { const int tok = e >> 6, pp = e & 63; YZ[(size_t)(b * SEQ + t0 + tok) * 2048 + hh * 64 + pp] = (bf16)f2bf(ys[e]); }
            if (tid < 128) { const int tok = tid >> 1, half = tid & 1; float s = 0.f;
                for (int i = 0; i < 32; ++i) { const float v = ys[tok * 64 + half * 32 + i]; s += v * v; }
                SSQ2[(size_t)(b * SEQ + t0 + tok) * 64 + hh * 2 + half] = s; }
            __syncthreads();
        }
        float* hp = a.out + O_HP + ((size_t)(b * SH + hh) * 64 + p) * 128 + nq * 16;
#pragma unroll
        for (int i4 = 0; i4 < 4; ++i4) *(f32x4*)(hp + 4 * i4) = (f32x4){h[4 * i4], h[4 * i4 + 1], h[4 * i4 + 2], h[4 * i4 + 3]};
    }
}

__device__ __forceinline__ void ssd_simple_decode(Frame& F, const Args& a) {
    unsigned char* ws = a.ws;
    const bf16* ZS = (const bf16*)(ws + WS_ZS); const float* DT = (const float*)(ws + WS_DT);
    bf16* YZ = (bf16*)(ws + WS_YZ); float* SSQ2 = (float*)(ws + WS_SSQ2);
    const float* cw = a.in[I_CW]; const float* cb = a.in[I_CB]; const float* sc = a.in[I_SC]; const float* h0 = a.in[I_SS];
    LAS float* xc = (LAS float*)(F.lds);
    LAS float* ys = xc + 320;
    int tid_ = F.wave * 64 + (int)__builtin_amdgcn_mbcnt_hi(~0u, __builtin_amdgcn_mbcnt_lo(~0u, 0u)); asm volatile("" : "+v"(tid_));
    const int tid = tid_, p = tid >> 3, nq = tid & 7;
    for (int item = F.vcu; item < DEC * SH; item += F.G) {
        const int b = item >> 5, hh = item & 31, g = hh >> 3, r = MP + b;
        if (tid < 320) {
            const int ch = tid; const int gch = ch < 64 ? hh * 64 + ch : (ch < 192 ? 2048 + g * 128 + (ch - 64) : 2560 + g * 128 + (ch - 192));
            float acc = cb[gch];
#pragma unroll
            for (int j = 0; j < 3; ++j) acc += cw[j * 3072 + gch] * sc[((size_t)b * 3 + j) * 3072 + gch];
            acc += cw[3 * 3072 + gch] * a.out[O_CS + ((size_t)b * 3 + 2) * 3072 + gch];
            xc[ch] = siluf_(acc);
        }
        __syncthreads();
        const float dt = DT[(size_t)r * 32 + hh], A = -__expf(a.in[I_ALOG][hh]), dA = __expf(dt * A), x = xc[p], dx = dt * x;
        const float* hin = h0 + ((size_t)(b * SH + hh) * 64 + p) * 128 + nq * 16;
        float* hout = a.out + O_HS + ((size_t)(b * SH + hh) * 64 + p) * 128 + nq * 16;
        float y = 0.f;
#pragma unroll
        for (int i4 = 0; i4 < 4; ++i4) {
            f32x4 hv = *(const f32x4*)(hin + 4 * i4);
#pragma unroll
            for (int e = 0; e < 4; ++e) { hv[e] = dA * hv[e] + dx * xc[64 + nq * 16 + 4 * i4 + e]; y += hv[e] * xc[192 + nq * 16 + 4 * i4 + e]; }
            *(f32x4*)(hout + 4 * i4) = hv;
        }
        y += __shfl_xor(y, 1); y += __shfl_xor(y, 2); y += __shfl_xor(y, 4);
        if (nq == 0) { const float yz = (y + a.in[I_DSK][hh] * x) * bf2f(ZS[(size_t)r * 2048 + hh * 64 + p]); ys[p] = yz; YZ[(size_t)r * 2048 + hh * 64 + p] = (bf16)f2bf(yz); }
        __syncthreads();
        if (tid < 2) { float s = 0.f; for (int i = 0; i < 32; ++i) { const float v = ys[tid * 32 + i]; s += v * v; } SSQ2[(size_t)r * 64 + hh * 2 + tid] = s; }
        __syncthreads();
    }
}


typedef float f32x16 __attribute__((ext_vector_type(16)));
typedef short bf16x8v __attribute__((ext_vector_type(8)));
typedef unsigned u32x2 __attribute__((ext_vector_type(2)));
__device__ __forceinline__ bf16x8v pack8(float a0, float a1, float a2, float a3, float a4, float a5, float a6, float a7) {
    u32x4 w; w.x = cvt_pk_bf16(a0, a1); w.y = cvt_pk_bf16(a2, a3); w.z = cvt_pk_bf16(a4, a5); w.w = cvt_pk_bf16(a6, a7);
    return __builtin_bit_cast(bf16x8v, w);
}
#define MFMA32(a, b, c) __builtin_amdgcn_mfma_f32_32x32x16_bf16((a), (b), (c), 0, 0, 0)

constexpr int AT_KS = 144, AT_VS = 520;
constexpr int AT_K_OFF = 0, AT_V_OFF = 256 * AT_KS;
__device__ __forceinline__ void attn_prompt_mfma(Frame& F, const Args& a) {
    unsigned char* ws = a.ws;
    const bf16* Q = (const bf16*)(ws + WS_Q); const bf16* Kb = (const bf16*)(ws + WS_K); const bf16* Vb = (const bf16*)(ws + WS_V); bf16* OA = (bf16*)(ws + WS_OA);
    int tid_ = F.wave * 64 + (int)__builtin_amdgcn_mbcnt_hi(~0u, __builtin_amdgcn_mbcnt_lo(~0u, 0u)); asm volatile("" : "+v"(tid_));
    const int tid = tid_, lane = tid & 63, wave = __builtin_amdgcn_readfirstlane(tid >> 6), r32 = lane & 31, hi = lane >> 5;
    LAS unsigned char* Ks = F.lds + AT_K_OFF; LAS unsigned char* VT = F.lds + AT_V_OFF;
    for (int item = F.vcu; item < NB * 16 * KVH; item += F.G) {
        const int kvh = item & 3, qblk = (item >> 2) & 15, b = item >> 6;
        const int row0 = b * SEQ + qblk * 128, krow0 = row0 - 128;
        __syncthreads();
        P_BEGIN(70, F.lds, wave);
        bf16x8v qfa[2][4];
        { const int hq_ = kvh * 4 + (wave >> 1);
#pragma unroll
          for (int bl = 0; bl < 2; ++bl)
#pragma unroll
              for (int ks = 0; ks < 4; ++ks) qfa[bl][ks] = *(const bf16x8v*)(Q + (size_t)(row0 + (wave & 1) * 64 + bl * 32 + r32) * 1024 + hq_ * 64 + ks * 16 + hi * 8); }
        {
            const int key = tid >> 1; int grow = krow0 + key; if (qblk == 0 && key < 128) grow = row0;
            const u32x4* src = (const u32x4*)(Kb + (size_t)grow * 256 + kvh * 64) + (tid & 1) * 4;
            const u32x4 v0 = src[0], v1 = src[1], v2 = src[2], v3 = src[3];
            LAS u32x4* dst = (LAS u32x4*)(Ks + key * AT_KS + (tid & 1) * 64);
            dst[0] = v0; dst[1] = v1; dst[2] = v2; dst[3] = v3;
        }
        {
            const int key = tid & 255, dh = tid >> 8; int grow = krow0 + key; if (qblk == 0 && key < 128) grow = row0;
            const u32x4* src = (const u32x4*)(Vb + (size_t)grow * 256 + kvh * 64 + dh * 32);
            const u32x4 v0 = src[0], v1 = src[1], v2 = src[2], v3 = src[3];
            LAS unsigned short* vt = (LAS unsigned short*)(VT + (dh * 32) * AT_VS + key * 2);
#define VT_W(c, v) do { vt[((c) * 8 + 0) * (AT_VS / 2)] = (unsigned short)(v.x & 0xffffu); vt[((c) * 8 + 1) * (AT_VS / 2)] = (unsigned short)(v.x >> 16); vt[((c) * 8 + 2) * (AT_VS / 2)] = (unsigned short)(v.y & 0xffffu); vt[((c) * 8 + 3) * (AT_VS / 2)] = (unsigned short)(v.y >> 16); \
                            vt[((c) * 8 + 4) * (AT_VS / 2)] = (unsigned short)(v.z & 0xffffu); vt[((c) * 8 + 5) * (AT_VS / 2)] = (unsigned short)(v.z >> 16); vt[((c) * 8 + 6) * (AT_VS / 2)] = (unsigned short)(v.w & 0xffffu); vt[((c) * 8 + 7) * (AT_VS / 2)] = (unsigned short)(v.w >> 16); } while (0)
            VT_W(0, v0); VT_W(1, v1); VT_W(2, v2); VT_W(3, v3);
#undef VT_W
        }
        __syncthreads();
        P_END(70, F.lds, wave); P_BEGIN(71, F.lds, wave);
        const int hq = kvh * 4 + (wave >> 1);
        const float sink = a.in[I_SINK][hq] * 1.4426950408889634f;
#pragma unroll 1
        for (int blk = 0; blk < 2; ++blk) {
            const int qo = (wave & 1) * 64 + blk * 32, kt0 = qo >> 5;
            const int qrow = row0 + qo + r32, qi = qo + r32;
            bf16x8v qf[4];
#pragma unroll
            for (int ks = 0; ks < 4; ++ks) qf[ks] = blk ? qfa[1][ks] : qfa[0][ks];
            f32x16 s[5];
#pragma unroll
            for (int tt = 0; tt < 5; ++tt) {
                f32x16 acc = {};
#pragma unroll
                for (int ks = 0; ks < 4; ++ks) { const bf16x8v kf = *(const LAS bf16x8v*)(Ks + ((kt0 + tt) * 32 + r32) * AT_KS + (ks * 16 + hi * 8) * 2); acc = MFMA32(kf, qf[ks], acc); }
                s[tt] = acc;
            }
            float mx = sink;
#pragma unroll
            for (int tt = 0; tt < 5; ++tt) {
                if (tt == 0 || tt == 4 || qblk == 0) {
#pragma unroll
                    for (int r = 0; r < 16; ++r) {
                        const int j = 32 * (kt0 + tt) + (r & 3) + 8 * (r >> 2) + 4 * hi;
                        const bool ok = (j > qi) && (j <= 128 + qi) && (qblk > 0 || j >= 128);
                        s[tt][r] = ok ? s[tt][r] : -INFINITY;
                    }
                }
#pragma unroll
                for (int r = 0; r < 16; ++r) mx = fmaxf(mx, s[tt][r]);
            }
            mx = fmaxf(mx, __shfl_xor(mx, 32));
            float l = 0.f;
#pragma unroll
            for (int tt = 0; tt < 5; ++tt)
#pragma unroll
                for (int r = 0; r < 16; ++r) { const float p = __builtin_amdgcn_exp2f(s[tt][r] - mx); s[tt][r] = p; l += p; }
            l += __shfl_xor(l, 32); l += __builtin_amdgcn_exp2f(sink - mx);
            f32x16 o0 = {}, o1 = {};
#pragma unroll
            for (int tt = 0; tt < 5; ++tt)
#pragma unroll
                for (int sk = 0; sk < 2; ++sk) {
                    const bf16x8v pf = pack8(s[tt][8 * sk], s[tt][8 * sk + 1], s[tt][8 * sk + 2], s[tt][8 * sk + 3], s[tt][8 * sk + 4], s[tt][8 * sk + 5], s[tt][8 * sk + 6], s[tt][8 * sk + 7]);
                    const int kbase = 32 * (kt0 + tt) + 16 * sk + 4 * hi;
                    const LAS unsigned char* v0p = VT + r32 * AT_VS + kbase * 2; const LAS unsigned char* v1p = v0p + 32 * AT_VS;
                    const u32x2 a0 = *(const LAS u32x2*)v0p, a1 = *(const LAS u32x2*)(v0p + 16), b0 = *(const LAS u32x2*)v1p, b1 = *(const LAS u32x2*)(v1p + 16);
                    const u32x4 av = {a0.x, a0.y, a1.x, a1.y}, bv = {b0.x, b0.y, b1.x, b1.y};
                    o0 = MFMA32(__builtin_bit_cast(bf16x8v, av), pf, o0); o1 = MFMA32(__builtin_bit_cast(bf16x8v, bv), pf, o1);
                }
            const float inv = frcp_(l);
            bf16* orow = OA + (size_t)qrow * 3072 + hq * 64 + 4 * hi;
#pragma unroll
            for (int g = 0; g < 4; ++g) {
                u32x2 w0, w1; w0.x = cvt_pk_bf16(o0[4 * g] * inv, o0[4 * g + 1] * inv); w0.y = cvt_pk_bf16(o0[4 * g + 2] * inv, o0[4 * g + 3] * inv);
                w1.x = cvt_pk_bf16(o1[4 * g] * inv, o1[4 * g + 1] * inv); w1.y = cvt_pk_bf16(o1[4 * g + 2] * inv, o1[4 * g + 3] * inv);
                *(u32x2*)(orow + 8 * g) = w0; *(u32x2*)(orow + 32 + 8 * g) = w1;
            }
        }
        P_END(71, F.lds, wave);
    }
}

constexpr int SD_RS = 272;
constexpr int SD_XT = 0, SD_BM = SD_XT + 64 * SD_RS, SD_CM = SD_BM + 128 * SD_RS, SD_BW = SD_CM + 128 * SD_RS, SD_HB = SD_BW + 128 * SD_RS, SD_SC = SD_HB + 64 * SD_RS;
constexpr int SD_SCB = 4112, SD_WL = SD_SC + 2 * SD_SCB, SD_XD = SD_WL + 5 * 320 * 4, SD_END = SD_XD + 2 * 776 * 4;
static_assert(SD_END <= LDSCTL_OFF, "SSD LDS map");

__device__ __forceinline__ void decode_conv_to_lds(Frame& F, const Args& a) {
    unsigned char* ws = a.ws;
    const float* cw = a.in[I_CW]; const float* cb = a.in[I_CB]; const float* DT = (const float*)(ws + WS_DT);
    int tid_ = F.wave * 64 + (int)__builtin_amdgcn_mbcnt_hi(~0u, __builtin_amdgcn_mbcnt_lo(~0u, 0u)); asm volatile("" : "+v"(tid_));
    LAS unsigned char* L = F.lds;
    {
            LAS float* XD = (LAS float*)(L + SD_XD);
            const float* sc = a.in[I_SC];
#pragma unroll
            for (int it = 0; it < 2; ++it) {
                const int ditem = F.vcu + F.G * it, db = ditem >> 2, dg = ditem & 3;
#pragma unroll
                for (int q = 0; q < 2; ++q) {
                    const int e = tid_ + 512 * q;
                    if (e < 768) {
                        const int gch = e < 512 ? 512 * dg + e : (e < 640 ? 2048 + 128 * dg + (e - 512) : 2560 + 128 * dg + (e - 640));
                        float acc = cb[gch] + cw[gch] * sc[((size_t)db * 3) * 3072 + gch] + cw[3072 + gch] * sc[((size_t)db * 3 + 1) * 3072 + gch] + cw[2 * 3072 + gch] * sc[((size_t)db * 3 + 2) * 3072 + gch]
                                  + cw[3 * 3072 + gch] * a.out[O_CS + ((size_t)db * 3 + 2) * 3072 + gch];
                        XD[it * 776 + e] = siluf_(acc);
                    }
                }
                if (tid_ < 8) XD[it * 776 + 768 + tid_] = DT[(size_t)(MP + db) * 32 + 8 * dg + tid_];
            }
        }
    __syncthreads();
}

template <bool DECF>
__device__ __forceinline__ void ssd_prompt_mfma(Frame& F, const Args& a) {
    unsigned char* ws = a.ws;
    const bf16* XBC = (const bf16*)(ws + WS_XBC); const bf16* ZS = (const bf16*)(ws + WS_ZS); const float* DT = (const float*)(ws + WS_DT); const bf16* HALO = (const bf16*)(ws + WS_HALO);
    bf16* YZ = (bf16*)(ws + WS_OA) + 1024; float* SSQ2 = (float*)(ws + WS_SSQ2);
    const float* cw = a.in[I_CW]; const float* cb = a.in[I_CB];
    int tid_ = F.wave * 64 + (int)__builtin_amdgcn_mbcnt_hi(~0u, __builtin_amdgcn_mbcnt_lo(~0u, 0u)); asm volatile("" : "+v"(tid_));
    const int lane = tid_ & 63, wave = __builtin_amdgcn_readfirstlane(tid_ >> 6), r32 = lane & 31, hi = lane >> 5;
    LAS unsigned char* L = F.lds;
    for (int item = F.vcu; item < NB * SH; item += F.G) {
        const int b = item >> 5, hh = item & 31, g = hh >> 3;
        const float A = -__expf(a.in[I_ALOG][hh]), Dk = a.in[I_DSK][hh];
        const int gchB = 2048 + g * 128 + 2 * lane, gchX = hh * 64 + 2 * (lane & 31);
#define GCH(i_) ((i_) < 2 ? gchB : ((i_) < 4 ? gchB + 512 : gchX))
        const int wC = (wave + 5) & 7, wX = (wave + 3) & 7;
#define TG(i_) ((i_) < 2 ? 2 * wave + ((i_) & 1) : ((i_) < 4 ? 2 * wC + ((i_) & 1) : 2 * wX + (lane >> 5)))
        unsigned voffB = (unsigned)gchB * 2u, voffX = (unsigned)gchX * 2u + (unsigned)(lane >> 5) * 8u * 6144u, voffXh = (unsigned)gchX * 2u;
        unsigned R[5][8], HR[6]; float dn0 = 0.f, dn1 = 0.f;
        const bool fixw = (wave == 0) || (wave == 3) || (wave == 5);
#define SSD_ISSUE_LOADS(c_, lo_, hi_) do { \
            const char* cb_ = (const char*)XBC + ((size_t)(b * XROWS + 8 + (c_) * 128) * 3072) * 2; \
            _Pragma("unroll") for (int i_ = (lo_); i_ < (hi_); ++i_) { \
                const char* rb_ = cb_ + (size_t)(16 * ((i_) < 2 ? wave : ((i_) < 4 ? wC : wX))) * 6144; \
                const unsigned vo_ = (i_) < 2 ? voffB + (unsigned)((i_) & 1) * 8u * 6144u : ((i_) < 4 ? voffB + 1024u + (unsigned)((i_) & 1) * 8u * 6144u : voffX); \
                _Pragma("unroll") for (int j_ = 0; j_ < 8; ++j_) R[i_][j_] = *(const unsigned*)(rb_ + (size_t)j_ * 6144 + vo_); } \
            if ((lo_) == 0 && fixw) { \
                const char* hb_ = (const char*)HALO + ((size_t)(b * 17 + (c_)) * 6 + 3) * 6144; \
                const unsigned vo_ = wave == 0 ? voffB : (wave == 3 ? voffB + 1024u : voffXh); \
                _Pragma("unroll") for (int j_ = 0; j_ < 6; ++j_) HR[j_] = *(const unsigned*)(hb_ + (size_t)j_ * 6144 + vo_); } } while (0)
#define SSD_ISSUE_DT(c_) do { if (wave == 7) { dn0 = DT[(size_t)(b * SEQ + (c_) * 128 + 2 * lane) * 32 + hh]; dn1 = DT[(size_t)(b * SEQ + (c_) * 128 + 2 * lane + 1) * 32 + hh]; } } while (0)
        {
            LAS float* WL = (LAS float*)(L + SD_WL);
            for (int e = tid_; e < 5 * 320; e += 512) { const int j = e / 320, ch = e % 320; const int gc = ch < 64 ? hh * 64 + ch : (ch < 192 ? 2048 + g * 128 + (ch - 64) : 2560 + g * 128 + (ch - 192)); WL[e] = j < 4 ? cw[j * 3072 + gc] : cb[gc]; }
        }
        asm volatile("" ::: "memory"); __builtin_amdgcn_sched_barrier(0);
#define SSD_SCAN(SCp_) do { \
            const float a0 = dn0 * A, a1 = dn1 * A, ps = a0 + a1; float sc = ps; \
            _Pragma("unroll") for (int o = 1; o < 64; o <<= 1) { const float t = __shfl_up(sc, o); if (lane >= o) sc += t; } \
            const float ex = sc - ps, c0 = ex + a0, c1 = ex + ps, cl = __shfl(sc, 63); \
            (SCp_)[2 * lane] = c0; (SCp_)[2 * lane + 1] = c1; (SCp_)[128 + 2 * lane] = dn0; (SCp_)[128 + 2 * lane + 1] = dn1; \
            (SCp_)[256 + 2 * lane] = __expf(cl - c0) * dn0; (SCp_)[256 + 2 * lane + 1] = __expf(cl - c1) * dn1; \
            (SCp_)[384 + 2 * lane] = __expf(c0); (SCp_)[384 + 2 * lane + 1] = __expf(c1); \
            if (lane == 0) (SCp_)[512] = __expf(cl); \
              \
            const float rf1 = __shfl(c1, 15), rf2 = __shfl(c1, 31), rf3 = __shfl(c1, 47); \
            const int ltl = lane >> 4; const float rfl = ltl == 1 ? rf1 : (ltl == 2 ? rf2 : rf3); \
            (SCp_)[516 + 2 * lane] = __expf(fminf(c0 - rfl, 0.f)); (SCp_)[516 + 2 * lane + 1] = __expf(fminf(c1 - rfl, 0.f)); \
            (SCp_)[644 + 2 * lane] = __expf(fminf(rf1 - c0, 0.f)) * dn0; (SCp_)[644 + 2 * lane + 1] = __expf(fminf(rf1 - c1, 0.f)) * dn1; \
            (SCp_)[772 + 2 * lane] = __expf(fminf(rf2 - c0, 0.f)) * dn0; (SCp_)[772 + 2 * lane + 1] = __expf(fminf(rf2 - c1, 0.f)) * dn1; \
            (SCp_)[900 + 2 * lane] = __expf(fminf(rf3 - c0, 0.f)) * dn0; (SCp_)[900 + 2 * lane + 1] = __expf(fminf(rf3 - c1, 0.f)) * dn1; } while (0)
        f32x4 hn[4] = {}; unsigned zn = 0u; float aln = 0.f, dkn = 0.f;
        const int dp = tid_ >> 3, dq = tid_ & 7;
#define DECS_LOAD(st_) do { const int it_ = F.vcu + F.G * ((st_) >> 3), bb_ = it_ >> 2, hh_ = 8 * (it_ & 3) + ((st_) & 7); \
            const float* hin_ = a.in[I_SS] + ((size_t)(bb_ * SH + hh_) * 64 + dp) * 128 + dq * 16; \
            _Pragma("unroll") for (int i_ = 0; i_ < 4; ++i_) hn[i_] = *(const f32x4*)(hin_ + 4 * i_); \
            zn = (unsigned)ZS[(size_t)(MP + bb_) * 2048 + hh_ * 64 + dp]; aln = a.in[I_ALOG][hh_]; dkn = a.in[I_DSK][hh_]; } while (0)
        if (DECF) { DECS_LOAD(0); }
        u32x2 zq[4], zqn[4];
#define SSD_ISSUE_Z(c_) do { const size_t yr_ = (size_t)(b * SEQ + (c_) * 128 + (wave >> 1) * 32 + r32); \
            _Pragma("unroll") for (int q_ = 0; q_ < 4; ++q_) zqn[q_] = *(const u32x2*)(ZS + yr_ * 2048 + hh * 64 + (wave & 1) * 32 + 8 * q_ + 4 * hi); } while (0)
        SSD_ISSUE_Z(0);
        SSD_ISSUE_LOADS(0, 0, 2); SSD_ISSUE_LOADS(0, 2, 5); SSD_ISSUE_DT(0);
        if (wave == 7) { SSD_SCAN((LAS float*)(L + SD_SC)); SSD_ISSUE_DT(1); }
        f32x16 hacc = {};
        const int nt = wave >> 1, pt = wave & 1, lt = wave >> 1;
#pragma unroll 1
        for (int c = 0; c < 16; ++c) {
            P_BEGIN(50, L, wave);
            LAS float* SC = (LAS float*)(L + SD_SC + (c & 1) * SD_SCB);
            asm volatile("" : "+v"(voffB), "+v"(voffX), "+v"(voffXh));
            __syncthreads();
            P_END(50, L, wave); P_BEGIN(51, L, wave);
            if (DECF) {
                const LAS float* XD = (const LAS float*)(L + SD_XD) + (c >> 3) * 776;
                const int ditem = F.vcu + F.G * (c >> 3), db = ditem >> 2, dhh = 8 * (ditem & 3) + (c & 7);
                const float ddt = XD[768 + (c & 7)], ddA = __expf(-ddt * __expf(aln)), dx_ = XD[64 * (c & 7) + dp], ddx = ddt * dx_;
                float* hout = a.out + O_HS + ((size_t)(db * SH + dhh) * 64 + dp) * 128 + dq * 16;
                float dy = 0.f;
#pragma unroll
                for (int i = 0; i < 4; ++i) {
                    const f32x4 bb = *(const LAS f32x4*)(XD + 512 + dq * 16 + 4 * i), cc = *(const LAS f32x4*)(XD + 640 + dq * 16 + 4 * i);
                    f32x4 hv = hn[i];
#pragma unroll
                    for (int e = 0; e < 4; ++e) { hv[e] = ddA * hv[e] + ddx * bb[e]; dy += hv[e] * cc[e]; }
                    *(f32x4*)(hout + 4 * i) = hv;
                }
                dy += __builtin_bit_cast(float, __builtin_amdgcn_update_dpp(0, __builtin_bit_cast(int, dy), 0xB1, 0xf, 0xf, true));
                dy += __builtin_bit_cast(float, __builtin_amdgcn_update_dpp(0, __builtin_bit_cast(int, dy), 0x4E, 0xf, 0xf, true));
                dy += __builtin_bit_cast(float, __builtin_amdgcn_update_dpp(0, __builtin_bit_cast(int, dy), 0x141, 0xf, 0xf, true));
                if (dq == 0) YZ[(size_t)(MP + db) * 3072 + dhh * 64 + dp] = (bf16)f2bf((dy + dkn * dx_) * __uint_as_float(zn << 16));
            }
#pragma unroll
            for (int q = 0; q < 4; ++q) zq[q] = zqn[q];
            asm volatile("" : "+v"(zq[0].x), "+v"(zq[0].y), "+v"(zq[1].x), "+v"(zq[1].y), "+v"(zq[2].x), "+v"(zq[2].y), "+v"(zq[3].x), "+v"(zq[3].y));
            if (c > 0) {
#pragma unroll
                for (int q = 0; q < 4; ++q) { u32x2 w; w.x = cvt_pk_bf16(hacc[4 * q], hacc[4 * q + 1]); w.y = cvt_pk_bf16(hacc[4 * q + 2], hacc[4 * q + 3]);
                    *(LAS u32x2*)(L + SD_HB + (pt * 32 + r32) * SD_RS + (nt * 32 + 8 * q + 4 * hi) * 2) = w; }
            }
#pragma unroll
            for (int i = 0; i < 5; ++i) {
                if ((i == 0 && wave == 0) || (i == 2 && wave == 3) || (i == 4 && wave == 5)) {
                    const int chl = i < 2 ? 64 + 2 * lane : (i < 4 ? 192 + 2 * lane : 2 * (lane & 31));
                    const LAS float* WL = (const LAS float*)(L + SD_WL) + chl;
                    typedef float f32x2w __attribute__((ext_vector_type(2)));
                    const f32x2w wq0 = *(const LAS f32x2w*)(WL), wq1 = *(const LAS f32x2w*)(WL + 320), wq2 = *(const LAS f32x2w*)(WL + 640), wq3 = *(const LAS f32x2w*)(WL + 960), bq = *(const LAS f32x2w*)(WL + 1280);
                    const bool mine = (i < 4) || (lane < 32);
#pragma unroll
                    for (int e = 0; e < 3; ++e) {
                        const float x0 = fmaf(wq3.x, bflo(HR[e + 3]), fmaf(wq2.x, bflo(HR[e + 2]), fmaf(wq1.x, bflo(HR[e + 1]), fmaf(wq0.x, bflo(HR[e]), bq.x))));
                        const float x1 = fmaf(wq3.y, bfhi(HR[e + 3]), fmaf(wq2.y, bfhi(HR[e + 2]), fmaf(wq1.y, bfhi(HR[e + 1]), fmaf(wq0.y, bfhi(HR[e]), bq.y))));
                        const unsigned pk = cvt_pk_bf16(siluf_(x0), siluf_(x1));
                        R[i][e] = mine ? pk : R[i][e];
                    }
                }
                const int s0 = 8 * TG(i);
                if (i < 2) {
#pragma unroll
                    for (int e = 0; e < 8; ++e) *(LAS unsigned*)(L + SD_BM + (s0 + e) * SD_RS + 4 * lane) = R[i][e];
                    float v0[8], v1[8];
#pragma unroll
                    for (int e = 0; e < 8; ++e) { v0[e] = bflo(R[i][e]); v1[e] = bfhi(R[i][e]); }
                    const f32x4 wa = *(const LAS f32x4*)(SC + 256 + s0), wb = *(const LAS f32x4*)(SC + 256 + s0 + 4);
                    *(LAS bf16x8v*)(L + SD_BW + (2 * lane) * SD_RS + s0 * 2) = pack8(v0[0] * wa[0], v0[1] * wa[1], v0[2] * wa[2], v0[3] * wa[3], v0[4] * wb[0], v0[5] * wb[1], v0[6] * wb[2], v0[7] * wb[3]);
                    *(LAS bf16x8v*)(L + SD_BW + (2 * lane + 1) * SD_RS + s0 * 2) = pack8(v1[0] * wa[0], v1[1] * wa[1], v1[2] * wa[2], v1[3] * wa[3], v1[4] * wb[0], v1[5] * wb[1], v1[6] * wb[2], v1[7] * wb[3]);
                } else if (i < 4) {
#pragma unroll
                    for (int e = 0; e < 8; ++e) *(LAS unsigned*)(L + SD_CM + (s0 + e) * SD_RS + 4 * lane) = R[i][e];
                } else {
                    const int p0 = 2 * (lane & 31);
                    u32x4 lo, hi_;
                    lo.x = __builtin_amdgcn_perm(R[4][1], R[4][0], 0x05040100u); lo.y = __builtin_amdgcn_perm(R[4][3], R[4][2], 0x05040100u); lo.z = __builtin_amdgcn_perm(R[4][5], R[4][4], 0x05040100u); lo.w = __builtin_amdgcn_perm(R[4][7], R[4][6], 0x05040100u);
                    hi_.x = __builtin_amdgcn_perm(R[4][1], R[4][0], 0x07060302u); hi_.y = __builtin_amdgcn_perm(R[4][3], R[4][2], 0x07060302u); hi_.z = __builtin_amdgcn_perm(R[4][5], R[4][4], 0x07060302u); hi_.w = __builtin_amdgcn_perm(R[4][7], R[4][6], 0x07060302u);
                    *(LAS u32x4*)(L + SD_XT + p0 * SD_RS + s0 * 2) = lo;
                    *(LAS u32x4*)(L + SD_XT + (p0 + 1) * SD_RS + s0 * 2) = hi_;
                }
            }
            const int ltok = lt * 32 + r32; const size_t yrow = (size_t)(b * SEQ + c * 128 + ltok);
            __syncthreads();
            P_END(51, L, wave); P_BEGIN(52, L, wave);
            if (c < 15) { SSD_ISSUE_LOADS(c + 1, 0, 2); SSD_ISSUE_Z(c + 1); if (DECF) DECS_LOAD(c + 1); }
            f32x16 cbt[2]; int tl[2], ts[2];
#pragma unroll
            for (int k = 0; k < 2; ++k) {
                const int idx = k == 0 ? wave : ((wave == 4 || wave == 5) ? wave + 4 : 99); cbt[k] = (f32x16){};
                { const int j = idx - 4; tl[k] = idx < 4 ? idx : (j < 1 ? 1 : (j < 3 ? 2 : 3)); ts[k] = idx < 4 ? idx : j - (tl[k] == 1 ? 0 : (tl[k] == 2 ? 1 : 3)); }
                if (idx < 10) {
#pragma unroll
                    for (int ks = 0; ks < 8; ++ks) {
                        const bf16x8v af = *(const LAS bf16x8v*)(L + SD_BM + (ts[k] * 32 + r32) * SD_RS + (ks * 16 + hi * 8) * 2);
                        const bf16x8v bf = *(const LAS bf16x8v*)(L + SD_CM + (tl[k] * 32 + r32) * SD_RS + (ks * 16 + hi * 8) * 2);
                        cbt[k] = MFMA32(af, bf, cbt[k]);
                    }
                }
            }
            {
                const float cd = SC[512];
                hacc = hacc * cd;
#pragma unroll
                for (int ks = 0; ks < 8; ++ks) {
                    const bf16x8v af = *(const LAS bf16x8v*)(L + SD_BW + (nt * 32 + r32) * SD_RS + (ks * 16 + hi * 8) * 2);
                    const bf16x8v bf = *(const LAS bf16x8v*)(L + SD_XT + (pt * 32 + r32) * SD_RS + (ks * 16 + hi * 8) * 2);
                    hacc = MFMA32(af, bf, hacc);
                }
            }
            __syncthreads();
            P_END(52, L, wave); P_BEGIN(53, L, wave);
            if (wave == 7 && c < 15) { SSD_SCAN((LAS float*)(L + SD_SC + ((c + 1) & 1) * SD_SCB)); if (c < 14) SSD_ISSUE_DT(c + 2); }
#pragma unroll
            for (int k = 0; k < 2; ++k) {
                if (k == 0 || wave == 4 || wave == 5) {
                    const int l = tl[k] * 32 + r32;
                    if (ts[k] < tl[k]) {
                        const float rf = SC[516 + l];
#pragma unroll
                        for (int q = 0; q < 4; ++q) {
                            const int sb = ts[k] * 32 + 8 * q + 4 * hi;
                            const f32x4 cf = *(const LAS f32x4*)(SC + 644 + (tl[k] - 1) * 128 + sb) * rf;
                            u32x2 w; w.x = cvt_pk_bf16(cbt[k][4 * q] * cf[0], cbt[k][4 * q + 1] * cf[1]); w.y = cvt_pk_bf16(cbt[k][4 * q + 2] * cf[2], cbt[k][4 * q + 3] * cf[3]);
                            *(LAS u32x2*)(L + SD_BM + l * SD_RS + sb * 2) = w;
                        }
                    } else {
                        const float cl_ = SC[l];
#pragma unroll
                        for (int q = 0; q < 4; ++q) {
                            const int sb = ts[k] * 32 + 8 * q + 4 * hi;
                            const f32x4 cs = *(const LAS f32x4*)(SC + sb), ds = *(const LAS f32x4*)(SC + 128 + sb);
                            float wv[4];
#pragma unroll
                            for (int e = 0; e < 4; ++e) { const float dcy = __expf(fminf(cl_ - cs[e], 0.f)) * ds[e]; wv[e] = (sb + e <= l) ? cbt[k][4 * q + e] * dcy : 0.f; }
                            u32x2 w; w.x = cvt_pk_bf16(wv[0], wv[1]); w.y = cvt_pk_bf16(wv[2], wv[3]);
                            *(LAS u32x2*)(L + SD_BM + l * SD_RS + sb * 2) = w;
                        }
                    }
                }
            }
            __syncthreads();
            P_END(53, L, wave); P_BEGIN(54, L, wave);
            if (c < 15) { SSD_ISSUE_LOADS(c + 1, 2, 5); }
            f32x16 ya = {}, yi = {};
#pragma unroll
            for (int st = 0; st < 4; ++st) {
                if (st <= lt) {
#pragma unroll
                    for (int k2 = 0; k2 < 2; ++k2) {
                        const int kk = st * 32 + k2 * 16 + hi * 8;
                        const bf16x8v af = *(const LAS bf16x8v*)(L + SD_XT + (pt * 32 + r32) * SD_RS + kk * 2);
                        const bf16x8v bf = *(const LAS bf16x8v*)(L + SD_BM + (lt * 32 + r32) * SD_RS + kk * 2);
                        ya = MFMA32(af, bf, ya);
                    }
                }
            }
            if (c > 0) {
#pragma unroll
                for (int ks = 0; ks < 8; ++ks) {
                    const bf16x8v af = *(const LAS bf16x8v*)(L + SD_HB + (pt * 32 + r32) * SD_RS + (ks * 16 + hi * 8) * 2);
                    const bf16x8v bf = *(const LAS bf16x8v*)(L + SD_CM + (lt * 32 + r32) * SD_RS + (ks * 16 + hi * 8) * 2);
                    yi = MFMA32(af, bf, yi);
                }
            }
            {
                const float el = SC[384 + ltok]; float ssq = 0.f;
#pragma unroll
                for (int q = 0; q < 4; ++q) {
                    const int p0 = pt * 32 + 8 * q + 4 * hi;
                    float y[4];
#pragma unroll
                    for (int e = 0; e < 4; ++e) { const float xv = bf2f(*(const LAS unsigned short*)(L + SD_XT + (p0 + e) * SD_RS + ltok * 2)); y[e] = ya[4 * q + e] + el * yi[4 * q + e] + Dk * xv; }
                    y[0] *= bflo(zq[q].x); y[1] *= bfhi(zq[q].x); y[2] *= bflo(zq[q].y); y[3] *= bfhi(zq[q].y);
                    ssq += (y[0] * y[0] + y[1] * y[1]) + (y[2] * y[2] + y[3] * y[3]);
                    u32x2 w; w.x = cvt_pk_bf16(y[0], y[1]); w.y = cvt_pk_bf16(y[2], y[3]);
                    *(u32x2*)(YZ + yrow * 3072 + hh * 64 + p0) = w;
                }
                ssq += __shfl_xor(ssq, 32);
                if (hi == 0) SSQ2[yrow * 64 + hh * 2 + pt] = ssq;
            }
            P_END(54, L, wave);
        }
        {
            float* hp = a.out + O_HP + ((size_t)(b * SH + hh) * 64 + pt * 32 + r32) * 128 + nt * 32 + 4 * hi;
#pragma unroll
            for (int q = 0; q < 4; ++q) *(f32x4*)(hp + 8 * q) = (f32x4){hacc[4 * q], hacc[4 * q + 1], hacc[4 * q + 2], hacc[4 * q + 3]};
        }
        __syncthreads();
    }
}


template <int KW, bool SSQ>
__device__ __forceinline__ void mini_acc(f32x16& acc, float& ssq, const bf16* wrow, const bf16* xrow) {
    constexpr int NS = KW / 16, BT = NS < 16 ? NS : 16;
#pragma unroll
    for (int s0 = 0; s0 < NS; s0 += BT) {
        bf16x8v wa[BT], xa[BT];
#pragma unroll
        for (int s = 0; s < BT; ++s) { wa[s] = *(const bf16x8v*)(wrow + 8 * (s0 + s)); xa[s] = *(const bf16x8v*)(xrow + 8 * (s0 + s)); }
#pragma unroll
        for (int s = 0; s < BT; ++s) {
            acc = MFMA32(wa[s], xa[s], acc);
            if (SSQ) {
                const u32x4 xw = __builtin_bit_cast(u32x4, xa[s]);
                ssq += bflo(xw.x) * bflo(xw.x) + bfhi(xw.x) * bfhi(xw.x) + bflo(xw.y) * bflo(xw.y) + bfhi(xw.y) * bfhi(xw.y) + bflo(xw.z) * bflo(xw.z) + bfhi(xw.z) * bfhi(xw.z) + bflo(xw.w) * bflo(xw.w) + bfhi(xw.w) * bfhi(xw.w);
            }
        }
    }
}
__device__ __forceinline__ void mini_reduce(LAS float* red, const f32x16& acc, int wave, int lane, float& o0, float& o1) {
#pragma unroll
    for (int r = 0; r < 16; ++r) red[(wave * 16 + r) * 64 + lane] = acc[r];
    __syncthreads();
    float a0 = 0.f, a1 = 0.f;
#pragma unroll
    for (int p = 0; p < 8; ++p) { a0 += red[(p * 16 + 2 * wave) * 64 + lane]; a1 += red[(p * 16 + 2 * wave + 1) * 64 + lane]; }
    o0 = a0; o1 = a1;
}
__device__ __forceinline__ float mini_reduce_ssq(LAS float* reds, float ssq, int wave, int lane) {
    reds[wave * 64 + lane] = ssq;
    __syncthreads();
    float s = 0.f;
#pragma unroll
    for (int p = 0; p < 8; ++p) s += reds[p * 64 + (lane & 31)] + reds[p * 64 + (lane & 31) + 32];
    return s;
}
template <int WHICH>
__device__ __forceinline__ void mini_gemm(Frame& F, const Args& a) {
    unsigned char* ws = a.ws;
    int tid_ = F.wave * 64 + (int)__builtin_amdgcn_mbcnt_hi(~0u, __builtin_amdgcn_mbcnt_lo(~0u, 0u)); asm volatile("" : "+v"(tid_));
    const int lane = tid_ & 63, wave = __builtin_amdgcn_readfirstlane(tid_ >> 6), r32 = lane & 31, hi = lane >> 5;
    LAS float* red = (LAS float*)F.lds; LAS float* red2 = red + 8 * 16 * 64; LAS float* reds = red2 + 8 * 16 * 64;
    const bf16* OA = (const bf16*)(ws + WS_OA); const bf16* YZ = (const bf16*)(ws + WS_OA) + 1024; const bf16* GT = (const bf16*)(ws + WS_GT);
    bf16* MIX = (bf16*)(ws + WS_XB); bf16* X1B = (bf16*)(ws + WS_OA); bf16* ACT = (bf16*)(ws + WS_ZS);
    constexpr int NT = (WHICH == 5 ? 4096 : 1024) / 32;
    for (int t = F.vcu; t < 4 * NT; t += F.G) {
        const int tt = t & 3, n0 = (t >> 2) * 32, tok = tt * 32 + r32, row = MP + tok;
        const int nl = 2 * (wave & 1) + 8 * (wave >> 1) + 4 * hi, n = n0 + nl;
        __syncthreads();
        if (WHICH == 3) {
            f32x16 acc1 = {}, acc2 = {}; float ssq = 0.f, d = 0.f;
            mini_acc<128, false>(acc1, d, (const bf16*)(ws + WS_WTA) + (size_t)(n0 + r32) * 3072 + wave * 128 + hi * 64, OA + (size_t)row * 3072 + wave * 128 + hi * 64);
            mini_acc<256, true>(acc2, ssq, (const bf16*)(ws + WS_WTA) + 1024 + (size_t)(n0 + r32) * 3072 + wave * 256 + hi * 128, YZ + (size_t)row * 3072 + wave * 256 + hi * 128);
            float p0, p1, q0, q1;
            mini_reduce(red, acc1, wave, lane, p0, p1); mini_reduce(red2, acc2, wave, lane, q0, q1);
            const float r2 = frsq_(mini_reduce_ssq(reds, ssq, wave, lane) * (1.0f / 2048.0f) + EPS);
            const unsigned ga = *(const unsigned*)(GT + (size_t)row * 2048 + n), gs = *(const unsigned*)(GT + (size_t)row * 2048 + 1024 + n);
            *(unsigned*)(MIX + (size_t)row * 1024 + n) = cvt_pk_bf16(bflo(ga) * p0 + bflo(gs) * r2 * q0, bfhi(ga) * p1 + bfhi(gs) * r2 * q1);
        } else if (WHICH == 4) {
            f32x16 acc = {}; float d = 0.f;
            mini_acc<128, false>(acc, d, (const bf16*)(ws + WS_WTO) + (size_t)(n0 + r32) * 1024 + wave * 128 + hi * 64, MIX + (size_t)row * 1024 + wave * 128 + hi * 64);
            float p0, p1; mini_reduce(red, acc, wave, lane, p0, p1);
            const float* xr = a.in[I_XS] + (size_t)tok * 1024 + n;
            const float v0 = xr[0] + p0, v1 = xr[1] + p1;
            *(unsigned*)(X1B + (size_t)row * 1024 + n) = cvt_pk_bf16(v0, v1);
        } else if (WHICH == 5) {
            f32x16 acc = {}; float ssq = 0.f;
            mini_acc<128, true>(acc, ssq, (const bf16*)(ws + WS_WTU) + (size_t)(n0 + r32) * 1024 + wave * 128 + hi * 64, X1B + (size_t)row * 1024 + wave * 128 + hi * 64);
            float p0, p1; mini_reduce(red, acc, wave, lane, p0, p1);
            const float r3 = frsq_(mini_reduce_ssq(reds, ssq, wave, lane) * (1.0f / 1024.0f) + EPS);
            float u0 = fmaxf(p0 * r3, 0.f), u1 = fmaxf(p1 * r3, 0.f);
            *(unsigned*)(ACT + (size_t)row * 4096 + n) = cvt_pk_bf16(u0 * u0, u1 * u1);
        } else {
            f32x16 acc = {}; float d = 0.f;
            mini_acc<512, false>(acc, d, (const bf16*)(ws + WS_WTD) + (size_t)(n0 + r32) * 4096 + wave * 512 + hi * 256, ACT + (size_t)row * 4096 + wave * 512 + hi * 256);
            float p0, p1; mini_reduce(red, acc, wave, lane, p0, p1);
            const unsigned xw = *(const unsigned*)(X1B + (size_t)row * 1024 + n);
            float* o = a.out + (size_t)row * 1024 + n; o[0] = bflo(xw) + p0; o[1] = bfhi(xw) + p1;
        }
    }
    __syncthreads();
}


__device__ __forceinline__ void ssd_decode_fast(Frame& F, const Args& a) {
    unsigned char* ws = a.ws;
    const bf16* ZS = (const bf16*)(ws + WS_ZS); const float* DT = (const float*)(ws + WS_DT); bf16* YZ = (bf16*)(ws + WS_OA) + 1024;
    const float* cw = a.in[I_CW]; const float* cb = a.in[I_CB]; const float* sc = a.in[I_SC]; const float* h0 = a.in[I_SS];
    LAS float* xc = (LAS float*)(F.lds);
    LAS float* dtv = xc + 768;
    int tid_ = F.wave * 64 + (int)__builtin_amdgcn_mbcnt_hi(~0u, __builtin_amdgcn_mbcnt_lo(~0u, 0u)); asm volatile("" : "+v"(tid_));
    const int tid = tid_, p = tid >> 3, nq = tid & 7;
    for (int item = F.vcu; item < DEC * SG; item += F.G) {
        const int b = item >> 2, g = item & 3, r = MP + b;
        __syncthreads();
        f32x4 hs[8][4];
#pragma unroll
        for (int j = 0; j < 8; ++j) { const float* hin = h0 + ((size_t)(b * SH + 8 * g + j) * 64 + p) * 128 + nq * 16;
#pragma unroll
            for (int i = 0; i < 4; ++i) hs[j][i] = *(const f32x4*)(hin + 4 * i); }
        float zsv[8];
#pragma unroll
        for (int j = 0; j < 8; ++j) zsv[j] = bf2f(ZS[(size_t)r * 2048 + (8 * g + j) * 64 + p]);
#pragma unroll
        for (int q = 0; q < 2; ++q) {
            const int e = tid + 512 * q;
            if (e < 768) {
                const int gch = e < 512 ? 512 * g + e : (e < 640 ? 2048 + 128 * g + (e - 512) : 2560 + 128 * g + (e - 640));
                float acc = cb[gch] + cw[gch] * sc[((size_t)b * 3) * 3072 + gch] + cw[3072 + gch] * sc[((size_t)b * 3 + 1) * 3072 + gch] + cw[2 * 3072 + gch] * sc[((size_t)b * 3 + 2) * 3072 + gch]
                          + cw[3 * 3072 + gch] * a.out[O_CS + ((size_t)b * 3 + 2) * 3072 + gch];
                xc[e] = siluf_(acc);
            }
        }
        if (tid < 8) dtv[tid] = DT[(size_t)r * 32 + 8 * g + tid];
        __syncthreads();
        float Bv[16], Cv[16];
#pragma unroll
        for (int i = 0; i < 4; ++i) { const f32x4 bb = *(const LAS f32x4*)(xc + 512 + nq * 16 + 4 * i), cc = *(const LAS f32x4*)(xc + 640 + nq * 16 + 4 * i);
            Bv[4 * i] = bb[0]; Bv[4 * i + 1] = bb[1]; Bv[4 * i + 2] = bb[2]; Bv[4 * i + 3] = bb[3]; Cv[4 * i] = cc[0]; Cv[4 * i + 1] = cc[1]; Cv[4 * i + 2] = cc[2]; Cv[4 * i + 3] = cc[3]; }
#pragma unroll
        for (int j = 0; j < 8; ++j) {
            const int hh = 8 * g + j;
            const float dt = dtv[j], dA = __expf(-dt * __expf(a.in[I_ALOG][hh])), x = xc[64 * j + p], dx = dt * x;
            float* hout = a.out + O_HS + ((size_t)(b * SH + hh) * 64 + p) * 128 + nq * 16;
            float y = 0.f;
#pragma unroll
            for (int i = 0; i < 4; ++i) { f32x4 hv = hs[j][i];
#pragma unroll
                for (int e = 0; e < 4; ++e) { hv[e] = dA * hv[e] + dx * Bv[4 * i + e]; y += hv[e] * Cv[4 * i + e]; }
                *(f32x4*)(hout + 4 * i) = hv; }
            y += __shfl_xor(y, 1); y += __shfl_xor(y, 2); y += __shfl_xor(y, 4);
            if (nq == 0) YZ[(size_t)r * 3072 + hh * 64 + p] = (bf16)f2bf((y + a.in[I_DSK][hh] * x) * zsv[j]);
        }
    }
    __syncthreads();
}

#ifndef GFLAG_A
#define GFLAG_A true
#define GFLAG_S true
#endif
#ifndef REP_MASK_UNUSED
#define REP_MASK_UNUSED 0
#endif
__global__ void __launch_bounds__(NWAVES * 64, 2) hybrid_fwd(Args args) {
    extern __shared__ __attribute__((aligned(16))) unsigned char lds[];
    Frame F;
    F.lds = (LAS unsigned char*)lds;
    volatile LAS unsigned* MISC = (volatile LAS unsigned*)(F.lds + MISC_OFF);
    F.wave = __builtin_amdgcn_readfirstlane(threadIdx.x >> 6);
    F.G = gridDim.x; { const int bx = blockIdx.x; F.vcu = (F.G % 8 == 0) ? (bx % 8) * (F.G / 8) + bx / 8 : bx; }
    unsigned char* ws = args.ws;
    gu32* ctl = (gu32*)(ws + WS_CTL);
    for (int u = threadIdx.x; u < (LDS_BYTES - LDSCTL_OFF) / 4; u += NWAVES * 64) ((LAS unsigned*)(F.lds + LDSCTL_OFF))[u] = 0u;
    __syncthreads();
    XcdBarrier bar = xcd_barrier_post((unsigned*)(ctl + CW_BAR), MISC + 8);
    P_BEGIN(60, F.lds, F.wave);
    const int lo = args.ph_lo, hi = args.ph_hi;
#ifndef PHASE_MASK
#define PHASE_MASK 0x7f
#endif
#define IN(k) ((((PHASE_MASK) >> (k)) & 1) && lo <= (k) && (k) < hi)
#define BOTH(k) (IN(k) && IN((k) + 1))
#define GRID_BAR() do { xcd_barrier(bar); if ((REP_MASK) & 0x400) xcd_barrier(bar); } while (0)

    bf16* WT1 = (bf16*)(ws + WS_WT1); bf16* WTA = (bf16*)(ws + WS_WTA); bf16* WTS = (bf16*)(ws + WS_WTS); bf16* WTO = (bf16*)(ws + WS_WTO); bf16* WTU = (bf16*)(ws + WS_WTU); bf16* WTD = (bf16*)(ws + WS_WTD);
    bf16* XB = (bf16*)(ws + WS_XB); bf16* Qb = (bf16*)(ws + WS_Q); bf16* Kb = (bf16*)(ws + WS_K); bf16* Vb = (bf16*)(ws + WS_V); bf16* OA = (bf16*)(ws + WS_OA);
    bf16* YZ = (bf16*)(ws + WS_YZ); bf16* GT = (bf16*)(ws + WS_GT); bf16* ZS = (bf16*)(ws + WS_ZS); bf16* XBC = (bf16*)(ws + WS_XBC);
    float* DT = (float*)(ws + WS_DT); float* SSQ2 = (float*)(ws + WS_SSQ2); float* SSQ3 = (float*)(ws + WS_SSQ3); float* ROPE = (float*)(ws + WS_ROPE);
    float* T1 = (float*)(ws + WS_ZS); bf16* MIX = XB; bf16* X1B = OA; bf16* ACT = ZS;

    P_BEGIN(1, F.lds, F.wave); if (IN(0)) { _Pragma("unroll 1") for (int rep = 0; rep < REPS(0); ++rep) p0_prologue(F, args); if (BOTH(0)) GRID_BAR(); } P_END(1, F.lds, F.wave);
    P_BEGIN(2, F.lds, F.wave);
    if (IN(1)) {
        pg8::Gemm g{XB, WT1, MPAD, N1, 1024}; pg8::StaticOrder S; S.init(MPAD, N1, F.G, (int)blockIdx.x);
        EpiIn E{ws, args.out, args.in[I_QN], args.in[I_KN], args.in[I_DTB], args.in[I_CW], args.in[I_CB]};
        _Pragma("unroll 1") for (int rep = 0; rep < REPS(1); ++rep) pg8::gemm_phase<EpiIn, pg8::StaticOrder, GFLAG_A, GFLAG_S, true>(F.lds + RING_OFF, g, S, E, F.wave);
        if (BOTH(1)) GRID_BAR();
    }
    P_END(2, F.lds, F.wave); P_BEGIN(3, F.lds, F.wave);
    if (IN(2)) {
#ifndef P2_MASK
#define P2_MASK 7
#endif
        const bool dec_first = ((blockIdx.x >> 3) & 1) == 0;
        if (F.G == NB * SH) {
            if (dec_first) { P_BEGIN(22, F.lds, F.wave); attn_simple<true>(F, args); P_END(22, F.lds, F.wave); }
            { _Pragma("unroll 1") for (int rep = 0; rep < REPS(3); ++rep) { P_BEGIN(20, F.lds, F.wave); attn_prompt_mfma(F, args); P_END(20, F.lds, F.wave); } }
            { P_BEGIN(23, F.lds, F.wave); decode_conv_to_lds(F, args); ssd_prompt_mfma<true>(F, args); P_END(23, F.lds, F.wave); }
            if (!dec_first) { P_BEGIN(22, F.lds, F.wave); attn_simple<true>(F, args); P_END(22, F.lds, F.wave); }
        }
        if (BOTH(2)) GRID_BAR();
    }
    P_END(3, F.lds, F.wave); P_BEGIN(4, F.lds, F.wave);
    if (IN(3)) {
        { pg8::Gemm g{OA, WTA, MP, 1024, 3072}; pg8::StaticOrder S; S.init(MP, 1024, F.G, (int)blockIdx.x);
          EpiMixF E{GT, SSQ2, MIX};
          _Pragma("unroll 1") for (int rep = 0; rep < REPS(5); ++rep) pg8::gemm_phase<EpiMixF, pg8::StaticOrder, true, true>(F.lds + RING_OFF, g, S, E, F.wave); }
        _Pragma("unroll 1") for (int rep = 0; rep < REPS(8); ++rep) mini_gemm<3>(F, args);
        if (BOTH(3)) GRID_BAR();
    }
    P_END(4, F.lds, F.wave); P_BEGIN(5, F.lds, F.wave);
    if (IN(4)) {
        pg8::Gemm g{MIX, WTO, MP, 1024, 1024}; pg8::StaticOrder S; S.init(MP, 1024, F.G, (int)blockIdx.x);
        EpiRes1 E{args.in[I_XP], args.in[I_XS], args.out, X1B, SSQ3};
        _Pragma("unroll 1") for (int rep = 0; rep < REPS(6); ++rep) pg8::gemm_phase<EpiRes1, pg8::StaticOrder, true, true>(F.lds + RING_OFF, g, S, E, F.wave);
        _Pragma("unroll 1") for (int rep = 0; rep < REPS(8); ++rep) mini_gemm<4>(F, args);
        if (BOTH(4)) GRID_BAR();
    }
    P_END(5, F.lds, F.wave); P_BEGIN(6, F.lds, F.wave);
    if (IN(5)) {
        pg8::Gemm g{X1B, WTU, MP, 4096, 1024}; pg8::StaticOrder S; S.init(MP, 4096, F.G, (int)blockIdx.x);
        EpiUp E{SSQ3, ACT};
        _Pragma("unroll 1") for (int rep = 0; rep < REPS(7); ++rep) pg8::gemm_phase<EpiUp, pg8::StaticOrder, GFLAG_A, GFLAG_S>(F.lds + RING_OFF, g, S, E, F.wave);
        _Pragma("unroll 1") for (int rep = 0; rep < REPS(8); ++rep) mini_gemm<5>(F, args);
        if (BOTH(5)) GRID_BAR();
    }
    P_END(6, F.lds, F.wave); P_BEGIN(7, F.lds, F.wave);
    if (IN(6)) {
        pg8::Gemm g{ACT, WTD, MP, 1024, 4096}; pg8::StaticOrder S; S.init(MP, 1024, F.G, (int)blockIdx.x);
        EpiDown E{X1B, args.out};
        pg8::gemm_phase<EpiDown, pg8::StaticOrder, true, true>(F.lds + RING_OFF, g, S, E, F.wave);
        mini_gemm<6>(F, args);
    }
    P_END(7, F.lds, F.wave);
    P_END(60, F.lds, F.wave);
#ifndef PROBE_MAX
#define PROBE_MAX 0
#endif
    if (PROBE_ID != 0 && PROBE_MAX) {
        if (F.wave == 0) atomicMax((unsigned*)(ws + WS_CTL + 8192), __float_as_uint(*(LAS float*)(F.lds + MISC_OFF + 72)));
        xcd_barrier(bar);
        if (blockIdx.x == 0 && F.wave == 0) args.out[O_KS] = 0.01f * __uint_as_float(*(volatile unsigned*)(ws + WS_CTL + 8192));
    } else
    if (PROBE_ID == 60 && blockIdx.x == 0 && F.wave == 0) args.out[0] = 0.001f * *(LAS float*)(F.lds + MISC_OFF + 72);
    else if (PROBE_ID != 0 && blockIdx.x == 0 && F.wave == 0) args.out[O_KS] = 0.01f * *(LAS float*)(F.lds + MISC_OFF + 72);
#undef IN
#undef BOTH
#undef GRID_BAR
}

#ifndef MK_N_LAUNCHES
#define MK_N_LAUNCHES 1
#endif
extern "C" void kernel_launch(void* const* d_in, const int* in_sizes, int n_in, void* d_out, int out_size, void* d_ws, size_t ws_size, hipStream_t stream) {
    static int grid = 0;
    if (grid == 0) {
        if (n_in != 23 || ws_size < WS_END || out_size != 62726144) { fprintf(stderr, "kernel_launch: unexpected n_in %d / ws %zu / out %d; nothing launched\n", n_in, ws_size, out_size); grid = -1; return; }
        int dev = 0, cus = 0, per_cu = 0;
        if (hipGetDevice(&dev) != hipSuccess || hipDeviceGetAttribute(&cus, hipDeviceAttributeMultiprocessorCount, dev) != hipSuccess) { grid = -1; return; }
        if (hipFuncSetAttribute((const void*)hybrid_fwd, hipFuncAttributeMaxDynamicSharedMemorySize, LDS_BYTES) != hipSuccess) { fprintf(stderr, "kernel_launch: hipFuncSetAttribute failed\n"); grid = -1; return; }
        if (hipOccupancyMaxActiveBlocksPerMultiprocessor(&per_cu, (const void*)hybrid_fwd, NWAVES * 64, LDS_BYTES) != hipSuccess || per_cu < 1) { fprintf(stderr, "kernel_launch: occupancy query reports %d blocks per CU\n", per_cu); per_cu = 1; }
        (void)hipGetLastError();
        grid = cus >= 256 ? 256 : cus;
    }
    if (grid < 0) return;
    if (hipMemsetAsync((char*)d_ws + WS_CTL, 0, CTL_ZERO_BYTES, stream) != hipSuccess) { fprintf(stderr, "kernel_launch: memset failed\n"); return; }
    Args a{};
    for (int i = 0; i < 23; ++i) a.in[i] = (const float*)d_in[i];
    a.out = (float*)d_out; a.ws = (unsigned char*)d_ws;
    for (int i = 0; i < 32; ++i) a.invf[i] = pow(10000.0, -(double)i / 32.0);
#if MK_N_LAUNCHES == 1
    a.ph_lo = 0; a.ph_hi = 7;
    void* kargs[] = {&a};
    hipError_t e = hipLaunchCooperativeKernel((const void*)hybrid_fwd, dim3(grid), dim3(NWAVES * 64), kargs, LDS_BYTES, stream);
    if (e != hipSuccess) fprintf(stderr, "kernel_launch: cooperative launch failed: %s (grid %d)\n", hipGetErrorString(e), grid);
#else
    for (int li = 0; li < 7; ++li) { a.ph_lo = li; a.ph_hi = li + 1; hipLaunchKernelGGL(hybrid_fwd, dim3(grid), dim3(NWAVES * 64), LDS_BYTES, stream, a); }
#endif
}
```

```cpp
#include <hip/hip_runtime.h>
#include <cstdio>
#include <cstdint>
#include <cmath>
#define REP_MASK 0
#define PROBE_ID 0
#define PROBE_MAX 0

#define LAS __attribute__((address_space(3)))
constexpr int LDS_BYTES = 163840;
constexpr int LDSCTL_OFF = LDS_BYTES - 512, MISC_OFF = LDSCTL_OFF + 320;
#ifndef PROBE_ID
#define PROBE_ID 0
#endif
#define P_BEGIN(id, ldsp, wv) do { if (PROBE_ID == (id) && (wv) == 0) *(LAS unsigned long long*)((ldsp) + MISC_OFF + 64) = __builtin_amdgcn_s_memrealtime(); } while (0)
#define P_END(id, ldsp, wv) do { if (PROBE_ID == (id) && (wv) == 0) *(LAS float*)((ldsp) + MISC_OFF + 72) += (float)(__builtin_amdgcn_s_memrealtime() - *(LAS unsigned long long*)((ldsp) + MISC_OFF + 64)); } while (0)
#define P_ENDMAX(id, ldsp, wv) do { if (PROBE_ID == (id) && (wv) == 0) { const float d_ = (float)(__builtin_amdgcn_s_memrealtime() - *(LAS unsigned long long*)((ldsp) + MISC_OFF + 64)); LAS float* a_ = (LAS float*)((ldsp) + MISC_OFF + 72); *a_ = fmaxf(*a_, d_); } } while (0)
namespace pg8 {
#define PG8_LAS __attribute__((address_space(3)))
typedef unsigned short bf16_t;
typedef short bf16x8 __attribute__((ext_vector_type(8)));
typedef float f32x4 __attribute__((ext_vector_type(4)));
typedef unsigned u32x4 __attribute__((ext_vector_type(4)));
constexpr int BM = 256, BK = 64, HALF = 128, HTB = HALF * BK * 2  , STAGE_BYTES = 8 * HTB, NXCD = 8, WGM = 7;

__host__ __device__ __forceinline__ int lds_byte(int r, int c) { const int st = (r >> 4) * 2 + (c >> 5), rr = r & 15, cc = c & 31, ob = rr * 64 + cc * 2; return st * 1024 + (ob ^ (((ob >> 9) & 1) << 5)); }
__host__ __device__ __forceinline__ void stage_rc(int b, int& R, int& C) { const int st = b / 1024, sb = b % 1024, swz = sb ^ (((sb >> 9) & 1) << 5); R = (st >> 1) * 16 + swz / 64; C = (st & 1) * 32 + (swz % 64) / 2; }
__host__ __device__ __forceinline__ int perm32(int rho) { const int n = rho >> 4, i = rho & 15; return 8 * (i >> 2) + 4 * n + (i & 3); }

struct Unit { int pm, pn; };
struct Gemm { const bf16_t* A; const bf16_t* Bt; int M, N, K; };

struct StaticOrder {
    int nM, nN, nwg, G, c, wgm;
    __host__ __device__ void init(int M, int N, int G_, int c_, int wgm_ = WGM) { nM = M / BM; nN = N / BM; nwg = nM * nN; G = G_; c = c_; wgm = wgm_; }
    __host__ __device__ bool next(int i, Unit& u) const {
        const long L = (long)i * G + c; if (L >= nwg) return false;
        int wgid = (int)L; { const int q = nwg / NXCD, r = nwg % NXCD, xcd = wgid % NXCD, off = wgid / NXCD; wgid = (xcd < r ? xcd * (q + 1) : r * (q + 1) + (xcd - r) * q) + off; }
        const int nig = wgm * nN, gid = wgid / nig, fm = gid * wgm, gsz = (nM - fm) < wgm ? (nM - fm) : wgm;
        u.pm = fm + ((wgid % nig) % gsz); u.pn = (wgid % nig) / gsz; return true;
    }
    __device__ __forceinline__ void a_ready(const Unit&) const {}
    __device__ __forceinline__ void done(const Unit&) const {}
};

__device__ __forceinline__ unsigned cvt_pk_bf16(float lo, float hi) { unsigned r; asm volatile("v_cvt_pk_bf16_f32 %0, %1, %2" : "=v"(r) : "v"(lo), "v"(hi)); return r; }
typedef float f32x2 __attribute__((ext_vector_type(2)));
template <class Epi, class Sched, bool ALIGN_EPI = false, bool SP2 = false, bool APERM = false>
__device__ __forceinline__ void gemm_phase(PG8_LAS unsigned char* lds, const Gemm g, const Sched& S, const Epi& E, const int wid_in) {
    int lane_ = (int)__builtin_amdgcn_mbcnt_hi(~0u, __builtin_amdgcn_mbcnt_lo(~0u, 0u)); asm volatile("" : "+v"(lane_));
    const int wid = wid_in, lane = lane_, tid = wid * 64 + lane, wr = wid >> 2, wc = wid & 3, fr = lane & 15, fq = lane >> 4;
    const int K = g.K, nt = K / BK;
    unsigned voffA[2], voffB[2];
#pragma unroll
    for (int i = 0; i < 2; ++i) { int R, C; stage_rc(tid * 16 + i * 8192, R, C); const int Rb = Epi::PERM ? ((R & ~31) + perm32(R & 31)) : R;
        const int Ra = APERM ? ((R >> 6) * 128 + (R & 15) * 8 + ((R >> 4) & 3)) : R;
        voffA[i] = (unsigned)(Ra * K + C) * 2u; voffB[i] = (unsigned)(Rb * K + C) * 2u; }
    const size_t kstep = (size_t)(BK * 2);
    const size_t hstep = (size_t)HALF * K * 2;
    const size_t hstepA = APERM ? (size_t)4 * K * 2 : hstep;
    const size_t tstep = 2 * hstep;
    const unsigned ldsw = (unsigned)wid * 1024u;
    const int aoff = lds_byte(wr * 64 + fr, fq * 8), boff = lds_byte(wc * 32 + fr, fq * 8);
#define PG8_SA(b, h) (((b) * 2 + (h)) * HTB)
#define PG8_SB(b, h) ((4 + (b) * 2 + (h)) * HTB)
#define PG8_STAGE(bufoff, gbase, voff) do { _Pragma("unroll") for (int _i = 0; _i < 2; ++_i) \
        __builtin_amdgcn_global_load_lds((const unsigned*)((const char*)(gbase) + (voff)[_i]), (PG8_LAS unsigned*)(lds + (bufoff) + ldsw + _i * 8192), 16, 0, 0); } while (0)
#define PG8_LDA(dst, b, h) do { _Pragma("unroll") for (int m = 0; m < 4; ++m) _Pragma("unroll") for (int k = 0; k < 2; ++k) dst[m][k] = *(const PG8_LAS bf16x8*)(lds + PG8_SA(b, h) + aoff + m * 2048 + k * 1024); } while (0)
#define PG8_LDB(dst, b, h) do { _Pragma("unroll") for (int n = 0; n < 2; ++n) _Pragma("unroll") for (int k = 0; k < 2; ++k) dst[n][k] = *(const PG8_LAS bf16x8*)(lds + PG8_SB(b, h) + boff + n * 2048 + k * 1024); } while (0)
#define PG8_MMA(ai, bj, At, Bt) do { __builtin_amdgcn_s_setprio(1); _Pragma("unroll") for (int m = 0; m < 4; ++m) _Pragma("unroll") for (int n = 0; n < 2; ++n) _Pragma("unroll") for (int k = 0; k < 2; ++k) \
        acc[ai][bj][m][n] = __builtin_amdgcn_mfma_f32_16x16x32_bf16(Bt[n][k], At[m][k], acc[ai][bj][m][n], 0, 0, 0); __builtin_amdgcn_s_setprio(0); } while (0)
#define PG8_WAIT_V(n) asm volatile("s_waitcnt vmcnt(" #n ")" ::: "memory")
#define PG8_WAIT_L(n) asm volatile("s_waitcnt lgkmcnt(" #n ")" ::: "memory")
#define PG8_BAR __builtin_amdgcn_s_barrier()
#define PG8_SCHED __builtin_amdgcn_sched_barrier(0)
    Unit cur, nxt; int ui = 0;
    if (!S.next(0, cur)) return;
    f32x4 acc[2][2][4][2];
#pragma unroll
    for (int a = 0; a < 2; ++a)
#pragma unroll
        for (int b = 0; b < 2; ++b)
#pragma unroll
            for (int m = 0; m < 4; ++m)
#pragma unroll
                for (int n = 0; n < 2; ++n) acc[a][b][m][n] = (f32x4){0.f, 0.f, 0.f, 0.f};
    bf16x8 At[4][2], B0[2][2], B1[2][2];
    const char* cA = (const char*)g.A + (size_t)cur.pm * tstep; const char* cB = (const char*)g.Bt + (size_t)cur.pn * tstep;
    S.a_ready(cur);
    if constexpr (SP2) {
        PG8_STAGE(PG8_SB(0, 0), cB, voffB); PG8_STAGE(PG8_SB(0, 1), cB + hstep, voffB); PG8_STAGE(PG8_SA(0, 0), cA, voffA); PG8_STAGE(PG8_SA(0, 1), cA + hstepA, voffA);
        if (wr == 1) PG8_BAR;
        PG8_WAIT_V(2); PG8_BAR;
        PG8_STAGE(PG8_SB(1, 0), cB + kstep, voffB); PG8_STAGE(PG8_SA(1, 0), cA + kstep, voffA); PG8_STAGE(PG8_SB(1, 1), cB + hstep + kstep, voffB);
        PG8_WAIT_V(6); PG8_BAR;
    } else {
        PG8_STAGE(PG8_SB(0, 0), cB, voffB); PG8_STAGE(PG8_SA(0, 0), cA, voffA); PG8_STAGE(PG8_SB(0, 1), cB + hstep, voffB); PG8_STAGE(PG8_SA(0, 1), cA + hstepA, voffA);
        if (wr == 1) PG8_BAR;
        PG8_WAIT_V(4); PG8_BAR;
        PG8_STAGE(PG8_SB(1, 0), cB + kstep, voffB); PG8_STAGE(PG8_SA(1, 0), cA + kstep, voffA); PG8_STAGE(PG8_SB(1, 1), cB + hstep + kstep, voffB);
        PG8_WAIT_V(6); PG8_BAR;
    }
    for (;;) {
        const bool has_next = S.next(ui + 1, nxt);
        const char* nA = has_next ? (const char*)g.A + (size_t)nxt.pm * tstep : cA; const char* nB = has_next ? (const char*)g.Bt + (size_t)nxt.pn * tstep : cB;
        for (int t = 0; t < nt; t += 2) {
            if constexpr (Epi::MIDT > 0) { if (t == Epi::MIDT) E.mid(acc, cur, wr, wc, fr, fq); }
            const bool last = (t == nt - 2);
            const char* a1 = cA + (size_t)(t + 1) * kstep;
            const char* a2 = last ? nA : cA + (size_t)(t + 2) * kstep; const char* b2 = last ? nB : cB + (size_t)(t + 2) * kstep;
            const char* a3 = a2 + kstep; const char* b3 = b2 + kstep;
            if (last && has_next) S.a_ready(nxt);
            if constexpr (SP2) {
            PG8_LDB(B0, 0, 0); PG8_LDB(B1, 0, 1); PG8_SCHED; PG8_LDA(At, 0, 0); PG8_STAGE(PG8_SA(1, 1), a1 + hstepA, voffA);
            PG8_WAIT_V(8); PG8_WAIT_L(0); PG8_BAR; PG8_MMA(0, 0, At, B0); PG8_MMA(0, 1, At, B1); PG8_BAR; PG8_SCHED;
            PG8_LDA(At, 0, 1); PG8_STAGE(PG8_SB(0, 0), b2, voffB); PG8_STAGE(PG8_SB(0, 1), b2 + hstep, voffB); PG8_STAGE(PG8_SA(0, 0), a2, voffA);
            PG8_WAIT_V(8); PG8_WAIT_L(0); PG8_BAR; PG8_MMA(1, 0, At, B0); PG8_MMA(1, 1, At, B1); PG8_BAR; PG8_SCHED;
            PG8_LDB(B0, 1, 0); PG8_LDB(B1, 1, 1); PG8_SCHED; PG8_LDA(At, 1, 0); PG8_STAGE(PG8_SA(0, 1), a2 + hstepA, voffA);
            PG8_WAIT_V(8); PG8_WAIT_L(0); PG8_BAR; PG8_MMA(0, 0, At, B0); PG8_MMA(0, 1, At, B1); PG8_BAR; PG8_SCHED;
            PG8_LDA(At, 1, 1); PG8_STAGE(PG8_SB(1, 0), b3, voffB); PG8_STAGE(PG8_SB(1, 1), b3 + hstep, voffB); PG8_STAGE(PG8_SA(1, 0), a3, voffA);
            PG8_WAIT_V(8); PG8_WAIT_L(0); PG8_BAR; PG8_MMA(1, 0, At, B0); PG8_MMA(1, 1, At, B1); PG8_BAR; PG8_SCHED;
            } else {
            PG8_LDB(B0, 0, 0); PG8_SCHED; PG8_LDA(At, 0, 0); PG8_STAGE(PG8_SA(1, 1), a1 + hstepA, voffA);
            PG8_WAIT_L(8); PG8_BAR; PG8_WAIT_L(0); PG8_MMA(0, 0, At, B0); PG8_BAR; PG8_SCHED;
            PG8_LDB(B1, 0, 1); PG8_STAGE(PG8_SB(0, 0), b2, voffB);
            PG8_BAR; PG8_WAIT_L(0); PG8_MMA(0, 1, At, B1); PG8_BAR;
            PG8_LDA(At, 0, 1); PG8_STAGE(PG8_SA(0, 0), a2, voffA);
            PG8_BAR; PG8_WAIT_L(0); PG8_MMA(1, 0, At, B0); PG8_BAR; PG8_SCHED;
            PG8_STAGE(PG8_SB(0, 1), b2 + hstep, voffB);
            PG8_WAIT_V(6); PG8_BAR; PG8_MMA(1, 1, At, B1); PG8_BAR;
            PG8_LDB(B0, 1, 0); PG8_SCHED; PG8_LDA(At, 1, 0); PG8_STAGE(PG8_SA(0, 1), a2 + hstepA, voffA);
            PG8_WAIT_L(8); PG8_BAR; PG8_WAIT_L(0); PG8_MMA(0, 0, At, B0); PG8_BAR; PG8_SCHED;
            PG8_LDB(B1, 1, 1); PG8_STAGE(PG8_SB(1, 0), b3, voffB);
            PG8_BAR; PG8_WAIT_L(0); PG8_MMA(0, 1, At, B1); PG8_BAR;
            PG8_LDA(At, 1, 1); PG8_STAGE(PG8_SA(1, 0), a3, voffA);
            PG8_BAR; PG8_WAIT_L(0); PG8_MMA(1, 0, At, B0); PG8_BAR; PG8_SCHED;
            PG8_STAGE(PG8_SB(1, 1), b3 + hstep, voffB);
            PG8_WAIT_V(6); PG8_BAR; PG8_MMA(1, 1, At, B1); PG8_BAR;
            }
        }
        if constexpr (ALIGN_EPI) { if (wr == 0) PG8_BAR; }
        if constexpr (!Epi::AFTER_DRAIN) { P_BEGIN(40 + Epi::PID, lds, wid); E(acc, cur, wr, wc, fr, fq); P_END(40 + Epi::PID, lds, wid); S.done(cur); }
        if (!has_next) break;
#pragma unroll
        for (int a = 0; a < 2; ++a)
#pragma unroll
            for (int b = 0; b < 2; ++b)
#pragma unroll
                for (int m = 0; m < 4; ++m)
#pragma unroll
                    for (int n = 0; n < 2; ++n) acc[a][b][m][n] = (f32x4){0.f, 0.f, 0.f, 0.f};
        cur = nxt; cA = nA; cB = nB; ++ui;
        if constexpr (ALIGN_EPI) { if (wr == 1) PG8_BAR; }
    }
    PG8_WAIT_V(0);
    if constexpr (!ALIGN_EPI) { if (wr == 0) PG8_BAR; }
    PG8_BAR;
    if constexpr (Epi::AFTER_DRAIN) { E.fused(acc, cur, wr, wc, fr, fq, lds, wid, lane); S.done(cur); }
#undef PG8_SA
#undef PG8_SB
#undef PG8_STAGE
#undef PG8_LDA
#undef PG8_LDB
#undef PG8_MMA
#undef PG8_WAIT_V
#undef PG8_WAIT_L
#undef PG8_BAR
#undef PG8_SCHED
}
}
#define GAS __attribute__((address_space(1)))
#define LAS __attribute__((address_space(3)))
typedef unsigned short bf16;
typedef unsigned v4u __attribute__((ext_vector_type(4)));
typedef float f32x4 __attribute__((ext_vector_type(4)));
typedef short bf16x8 __attribute__((ext_vector_type(8)));
typedef GAS unsigned gu32;
typedef GAS unsigned long long gu64;
#define RLX_AGENT __ATOMIC_RELAXED, __HIP_MEMORY_SCOPE_AGENT
#define LDS_WAIT() asm volatile("s_waitcnt lgkmcnt(0)" ::: "memory")
#define VM_WAIT() asm volatile("s_waitcnt vmcnt(0)" ::: "memory")
__device__ __forceinline__ unsigned long long rt() { return __builtin_amdgcn_s_memrealtime(); }
__device__ __forceinline__ unsigned f2bf(float f) { unsigned u = __builtin_bit_cast(unsigned, f); return (u + 0x7fffu + ((u >> 16) & 1u)) >> 16; }
__device__ __forceinline__ unsigned pk2(float lo, float hi) { return f2bf(lo) | (f2bf(hi) << 16); }

#define XB_TMO      128
#define XB_XCNT(j)  (256  + 64 * (j))
#define XB_XSUB(j)  (1280 + 64 * (j))
#define XB_XGEN(j)  (2304 + 64 * (j))
#define XB_TOP      3328
#define XB_TOPGEN   3392
#define XCD_BAR_WORDS 3456
#define XB_SPIN_CAP (1u << 18)

__device__ __forceinline__ unsigned xb_ld(unsigned* p)              { return __hip_atomic_load(p, __ATOMIC_RELAXED, __HIP_MEMORY_SCOPE_AGENT); }
__device__ __forceinline__ unsigned xb_add(unsigned* p, unsigned v) { return __hip_atomic_fetch_add(p, v, __ATOMIC_RELAXED, __HIP_MEMORY_SCOPE_AGENT); }
__device__ __forceinline__ unsigned xb_xcc_id() { return (unsigned)__builtin_amdgcn_s_getreg((3 << 11) | 20) & 0xFu; }
#define XB_SPIN(cond, bar) do { unsigned _sp = 0; while (cond) { __builtin_amdgcn_s_sleep(1); \
    if ((++_sp & 255u) == 0u) { if (xb_ld(&(bar)[XB_TMO])) break; if (_sp > XB_SPIN_CAP) { atomicAdd(&(bar)[XB_TMO], 1u); break; } } } } while (0)

struct XcdBarrier {
    unsigned* bar; unsigned x;
    volatile LAS unsigned* st;
};

__device__ __forceinline__ XcdBarrier xcd_barrier_post(unsigned* bar, volatile LAS unsigned* st) {
    XcdBarrier b; b.bar = bar; b.x = xb_xcc_id(); b.st = st;
    if (threadIdx.x == 0) (void)xb_add(&bar[XB_XCNT(b.x)], 1u);
    return b;
}
__device__ __forceinline__ void xcd_barrier_complete(unsigned* bar, unsigned x, unsigned& nloc, unsigned& nx) {
    const unsigned G = gridDim.x * gridDim.y * gridDim.z;
    unsigned sum, cnt, mine, sp = 0u;
    for (;;) {
        sum = 0u; cnt = 0u; mine = 0u;
#pragma unroll
        for (unsigned j = 0; j < 16; ++j) { const unsigned c = xb_ld(&bar[XB_XCNT(j)]); sum += c; cnt += (c > 0u) ? 1u : 0u; mine = (j == x) ? c : mine; }
        if (sum == G) break;
        __builtin_amdgcn_s_sleep(1);
        if ((++sp & 255u) == 0u) { if (xb_ld(&bar[XB_TMO])) break; if (sp > XB_SPIN_CAP) { atomicAdd(&bar[XB_TMO], 1u); break; } }
    }
    nloc = mine > 0u ? mine : 1u; nx = cnt > 0u ? cnt : 1u;
}

__device__ __forceinline__ void xcd_barrier(const XcdBarrier& b) {
    asm volatile("s_waitcnt vmcnt(0)" ::: "memory");
    __syncthreads();
    if (threadIdx.x == 0) {
        unsigned* bar = b.bar;
        __builtin_amdgcn_s_waitcnt(0);
        unsigned nloc = b.st[0], nx = b.st[1];
        if (nloc == 0u) { xcd_barrier_complete(bar, b.x, nloc, nx); b.st[0] = nloc; b.st[1] = nx; }
        const unsigned old = xb_add(&bar[XB_XSUB(b.x)], 1u);
        const unsigned gen = old / nloc;
        if (old + 1u == (gen + 1u) * nloc) {
            __builtin_amdgcn_fence(__ATOMIC_RELEASE, "agent");
            asm volatile("s_waitcnt vmcnt(0)" ::: "memory");
            const unsigned og = xb_add(&bar[XB_TOP], 1u);
            const unsigned tg = og / nx;
            if (og + 1u == (tg + 1u) * nx) xb_add(&bar[XB_TOPGEN], 1u);
            else XB_SPIN(xb_ld(&bar[XB_TOPGEN]) == tg, bar);
            __builtin_amdgcn_fence(__ATOMIC_ACQUIRE, "agent");
            xb_add(&bar[XB_XGEN(b.x)], 1u);
            asm volatile("s_waitcnt vmcnt(0)" ::: "memory");
        } else {
            XB_SPIN(xb_ld(&bar[XB_XGEN(b.x)]) == gen, bar);
            __builtin_amdgcn_fence(__ATOMIC_ACQUIRE, "agent");
            asm volatile("s_waitcnt vmcnt(0)" ::: "memory");
        }
    }
    __syncthreads();
}

constexpr int NWAVES = 8;
constexpr int DM = 1024, NB = 8, SEQ = 2048, MP = NB * SEQ, DEC = 128, MTOK = MP + DEC, MPAD = 16640;
constexpr int NH = 16, KVH = 4, HD = 64, WIN = 128;
constexpr int DI = 2048, SH = 32, SP = 64, SG = 4, SN = 128, CONVD = 3072, FF = 4096;
constexpr int XROWS = SEQ + 8;
constexpr int N1 = 8960;
constexpr float EPS = 1e-6f;
constexpr size_t O_YP = 0, O_YS = 16777216, O_KP = 16908288, O_VP = 17170432, O_CP = 17432576, O_HP = 17506304, O_KS = 19603456, O_VS = 23797760, O_CS = 27992064, O_HS = 29171712;

constexpr size_t MiB = 1u << 20;
constexpr size_t WS_CTL = 0, CTL_ZERO_BYTES = 32768;
constexpr size_t WS_WT1 = 1 * MiB;
constexpr size_t WS_WTA = 19 * MiB;
constexpr size_t WS_WTS = 21 * MiB;
constexpr size_t WS_WTO = 25 * MiB;
constexpr size_t WS_WTU = 27 * MiB;
constexpr size_t WS_WTD = 35 * MiB;
constexpr size_t WS_ROPE = 43 * MiB;
constexpr size_t WS_DT = 44 * MiB;
constexpr size_t WS_SSQ2 = 47 * MiB;
constexpr size_t WS_SSQ3 = 52 * MiB;
constexpr size_t WS_XB = 54 * MiB;
constexpr size_t WS_Q = 87 * MiB;
constexpr size_t WS_K = 120 * MiB;
constexpr size_t WS_V = 129 * MiB;
constexpr size_t WS_OA = 138 * MiB;
constexpr size_t WS_YZ = 171 * MiB;
constexpr size_t WS_GT = 236 * MiB;
constexpr size_t WS_ZS = 301 * MiB;
constexpr size_t WS_XBC = 366 * MiB;
constexpr size_t WS_HALO = 464 * MiB;
constexpr size_t WS_END = 470 * MiB;
static_assert(WS_XB + (size_t)MPAD * 1024 * 2 <= WS_Q && WS_Q + (size_t)MPAD * 1024 * 2 <= WS_K && WS_K + (size_t)MPAD * 256 * 2 <= WS_V && WS_V + (size_t)MPAD * 256 * 2 <= WS_OA, "ws map 1");
static_assert(WS_OA + (size_t)MPAD * 1024 * 2 <= WS_YZ && WS_YZ + (size_t)MPAD * 2048 * 2 <= WS_GT && WS_GT + (size_t)MPAD * 2048 * 2 <= WS_ZS && WS_ZS + (size_t)MPAD * 2048 * 2 <= WS_XBC && WS_XBC + (size_t)MPAD * 3072 * 2 <= WS_END, "ws map 2");
static_assert(WS_ZS + (size_t)MPAD * 4096 * 2 <= WS_END && WS_WT1 + (size_t)N1 * 1024 * 2 <= WS_WTA && WS_DT + (size_t)MPAD * 32 * 4 <= WS_SSQ2 && WS_SSQ2 + (size_t)MPAD * 64 * 4 <= WS_SSQ3 && WS_SSQ3 + (size_t)MPAD * 16 * 4 <= WS_XB, "ws map 3");
constexpr int CW_TMO = 0, CW_BAR = 4096;

constexpr int RING_OFF = 0, RING_BYTES = 131072;

__device__ __forceinline__ float bf2f(unsigned short b) { return __uint_as_float((unsigned)b << 16); }
__device__ __forceinline__ float bflo(unsigned w) { return __uint_as_float(w << 16); }
__device__ __forceinline__ float bfhi(unsigned w) { return __uint_as_float(w & 0xffff0000u); }
__device__ __forceinline__ float frcp_(float v) { return __builtin_amdgcn_rcpf(v); }
__device__ __forceinline__ float frsq_(float v) { return __builtin_amdgcn_rsqf(v); }
__device__ __forceinline__ float sigmoidf_(float v) { return frcp_(1.0f + __expf(-v)); }
__device__ __forceinline__ float siluf_(float v) { return v * frcp_(1.0f + __expf(-v)); }
__device__ __forceinline__ f32x4 sigmoid4_(f32x4 v) { const f32x4 t = v * -1.4426950408889634f; f32x4 e; e[0] = __builtin_amdgcn_exp2f(t[0]); e[1] = __builtin_amdgcn_exp2f(t[1]); e[2] = __builtin_amdgcn_exp2f(t[2]); e[3] = __builtin_amdgcn_exp2f(t[3]);
    const f32x4 d = e + 1.0f; f32x4 r; r[0] = frcp_(d[0]); r[1] = frcp_(d[1]); r[2] = frcp_(d[2]); r[3] = frcp_(d[3]); return r; }
__device__ __forceinline__ f32x4 silu4_(f32x4 v) { return v * sigmoid4_(v); }

#ifndef REP_MASK
#define REP_MASK 0
#endif
__device__ __forceinline__ int rep_count(int n) { asm volatile("" : "+s"(n)); return n; }
#define REPS(bit) rep_count((((REP_MASK) >> (bit)) & 1) ? 2 : 1)
__device__ __forceinline__ float sum_fq(float v) {
    v += __uint_as_float((unsigned)__builtin_amdgcn_ds_swizzle((int)__float_as_uint(v), 0x401F));
    const auto rr = __builtin_amdgcn_permlane32_swap(__float_as_uint(v), __float_as_uint(v), false, false);
    return __uint_as_float(rr[0]) + __uint_as_float(rr[1]);
}
using pg8::Unit; using pg8::cvt_pk_bf16; using pg8::bf16_t;
typedef unsigned u32x4 __attribute__((ext_vector_type(4)));

__device__ __forceinline__ f32x4 dpp_shr1(const f32x4& v) {
    f32x4 o; float o0, o1, o2, o3;
    asm volatile("s_nop 1\n\tv_mov_b32_dpp %0, %4 row_shr:1 row_mask:0xf bank_mask:0xf bound_ctrl:1\n\tv_mov_b32_dpp %1, %5 row_shr:1 row_mask:0xf bank_mask:0xf bound_ctrl:1\n\t"
                 "v_mov_b32_dpp %2, %6 row_shr:1 row_mask:0xf bank_mask:0xf bound_ctrl:1\n\tv_mov_b32_dpp %3, %7 row_shr:1 row_mask:0xf bank_mask:0xf bound_ctrl:1"
                 : "=&v"(o0), "=&v"(o1), "=&v"(o2), "=&v"(o3) : "v"(v[0]), "v"(v[1]), "v"(v[2]), "v"(v[3]));
    o[0] = o0; o[1] = o1; o[2] = o2; o[3] = o3;
    return o;
}
struct EpiIn {
    static constexpr bool PERM = true, AFTER_DRAIN = false; static constexpr int PID = 1; static constexpr int MIDT = 0;
    unsigned char* wsb; float* out; const float *qn, *kn, *dtb, *cw, *cb;
    __device__ __forceinline__ void operator()(const f32x4 (&acc)[2][2][4][2], const Unit& u, int wr, int wc, int fr, int fq) const {
        bf16_t* const Q = (bf16_t*)(wsb + WS_Q); bf16_t* const Kb = (bf16_t*)(wsb + WS_K); bf16_t* const Vb = (bf16_t*)(wsb + WS_V); bf16_t* const ZS = (bf16_t*)(wsb + WS_ZS); bf16_t* const XBC = (bf16_t*)(wsb + WS_XBC);
        bf16_t* const GT = (bf16_t*)(wsb + WS_GT); bf16_t* const HALO = (bf16_t*)(wsb + WS_HALO); float* const DT = (float*)(wsb + WS_DT); const float* const rope = (const float*)(wsb + WS_ROPE);
        asm volatile("" : "+v"(fr), "+v"(fq));
        const int pn = u.pn;
        if (u.pm == 64 && wr == 1) return;
        const int rbase = u.pm * 256 + wr * 128 + fr * 8;
        if (pn <= 4) {
            const bool isq = pn < 4;
            const float* gw = isq ? qn : kn;
            f32x4 g[2][2];
#pragma unroll
            for (int bj = 0; bj < 2; ++bj)
#pragma unroll
                for (int n = 0; n < 2; ++n) g[bj][n] = *(const f32x4*)(gw + 32 * bj + 8 * fq + 4 * n);
            const float osc = isq ? 0.125f * 1.4426950408889634f : 1.0f;
            f32x4 rc[2], rs_[2], c1[2], s1[2];
            { const int tp0 = rbase < MP ? (rbase & (SEQ - 1)) : SEQ; const float* rp = rope + (size_t)tp0 * 64 + 8 * fq; const float* r1 = rope + 64 + 8 * fq;
              rc[0] = *(const f32x4*)rp; rc[1] = *(const f32x4*)(rp + 4); rs_[0] = *(const f32x4*)(rp + 32); rs_[1] = *(const f32x4*)(rp + 36);
              c1[0] = *(const f32x4*)r1; c1[1] = *(const f32x4*)(r1 + 4); s1[0] = *(const f32x4*)(r1 + 32); s1[1] = *(const f32x4*)(r1 + 36);
              if (rbase >= MP) { c1[0] = c1[1] = (f32x4){1.f, 1.f, 1.f, 1.f}; s1[0] = s1[1] = (f32x4){0.f, 0.f, 0.f, 0.f}; } }
#pragma unroll
            for (int idx = 0; idx < 8; ++idx) {
                const int ai = idx >> 2, m = idx & 3;
                const int r = rbase + idx;
                float ss = 0.f;
#pragma unroll
                for (int bj = 0; bj < 2; ++bj)
#pragma unroll
                    for (int n = 0; n < 2; ++n) { const f32x4 v = acc[ai][bj][m][n]; ss += (v[0] * v[0] + v[1] * v[1]) + (v[2] * v[2] + v[3] * v[3]); }
                ss = sum_fq(ss);
                const float rs = frsq_(ss * (1.0f / 64.0f) + EPS);
                f32x4 o1[2], o2[2];
#pragma unroll
                for (int n = 0; n < 2; ++n) {
                    const f32x4 x1 = acc[ai][0][m][n] * rs * g[0][n], x2 = acc[ai][1][m][n] * rs * g[1][n];
                    o1[n] = (x1 * rc[n] - x2 * rs_[n]) * osc; o2[n] = (x2 * rc[n] + x1 * rs_[n]) * osc;
                }
                u32x4 w1, w2;
                w1.x = cvt_pk_bf16(o1[0][0], o1[0][1]); w1.y = cvt_pk_bf16(o1[0][2], o1[0][3]); w1.z = cvt_pk_bf16(o1[1][0], o1[1][1]); w1.w = cvt_pk_bf16(o1[1][2], o1[1][3]);
                w2.x = cvt_pk_bf16(o2[0][0], o2[0][1]); w2.y = cvt_pk_bf16(o2[0][2], o2[0][3]); w2.z = cvt_pk_bf16(o2[1][0], o2[1][1]); w2.w = cvt_pk_bf16(o2[1][2], o2[1][3]);
                if (isq) {
                    bf16_t* dst = Q + (size_t)r * 1024 + (pn * 4 + wc) * 64 + 8 * fq;
                    *(u32x4*)dst = w1; *(u32x4*)(dst + 32) = w2;
                } else {
                    bf16_t* dst = Kb + (size_t)r * 256 + wc * 64 + 8 * fq;
                    *(u32x4*)dst = w1; *(u32x4*)(dst + 32) = w2;
                    float* fo = nullptr;
                    if (r >= MP) fo = out + O_KS + ((size_t)(r - MP) * 128 + 127) * 256;
                    else if ((r & (SEQ - 1)) >= SEQ - WIN) fo = out + O_KP + ((size_t)(r >> 11) * 128 + ((r & (SEQ - 1)) - (SEQ - WIN))) * 256;
                    if (fo) { fo += wc * 64 + 8 * fq; *(f32x4*)fo = o1[0]; *(f32x4*)(fo + 4) = o1[1]; *(f32x4*)(fo + 32) = o2[0]; *(f32x4*)(fo + 36) = o2[1]; }
                }
#pragma unroll
                for (int n = 0; n < 2; ++n) { const f32x4 cn = rc[n] * c1[n] - rs_[n] * s1[n], sn = rs_[n] * c1[n] + rc[n] * s1[n]; rc[n] = cn; rs_[n] = sn; }
            }
        } else if (pn == 34) {
            if (wc == 0) {
                f32x4 b0 = *(const f32x4*)(dtb + 8 * fq), b1 = *(const f32x4*)(dtb + 8 * fq + 4);
#pragma unroll
                for (int ai = 0; ai < 2; ++ai) {
#pragma unroll
                    for (int m = 0; m < 4; ++m) {
                        const int r = rbase + 4 * ai + m;
                        f32x4 v0 = acc[ai][0][m][0] + b0, v1 = acc[ai][0][m][1] + b1;
#pragma unroll
                        for (int e = 0; e < 4; ++e) { v0[e] = fmaxf(v0[e], 0.f) + 0.69314718056f * __builtin_amdgcn_logf(1.0f + __expf(-fabsf(v0[e]))); v1[e] = fmaxf(v1[e], 0.f) + 0.69314718056f * __builtin_amdgcn_logf(1.0f + __expf(-fabsf(v1[e]))); }
                        float* d = DT + (size_t)r * 32 + 8 * fq; *(f32x4*)d = v0; *(f32x4*)(d + 4) = v1;
                    }
                }
            }
        } else if (pn >= 14 && pn < 26) {
            const int cg0 = (pn - 14) * 256 + wc * 32 + 8 * fq;
            const bool dec = (u.pm == 64);
            if (dec) {
#pragma unroll
                for (int bj = 0; bj < 2; ++bj)
#pragma unroll
                    for (int ai = 0; ai < 2; ++ai)
#pragma unroll
                        for (int m = 0; m < 4; ++m) { float* f = out + O_CS + ((size_t)(rbase - MP + 4 * ai + m) * 3 + 2) * 3072 + cg0 + 128 * bj; *(f32x4*)f = acc[ai][bj][m][0]; *(f32x4*)(f + 4) = acc[ai][bj][m][1]; }
            } else {
                f32x4 wc_[4], bc_, wn_[4] = {}, bn_ = {};
                bc_ = *(const f32x4*)(cb + cg0);
#pragma unroll
                for (int j = 0; j < 4; ++j) wc_[j] = *(const f32x4*)(cw + j * 3072 + cg0);
                const int run = rbase >> 7, hent = (run >> 4) * 17 + 1 + (run & 15);
#pragma unroll
                for (int bj = 0; bj < 2; ++bj) {
                    const int cg = cg0 + 128 * bj;
                    if (fr == 0) {
#pragma unroll
                        for (int m = 0; m < 3; ++m) { u32x4 w; w.x = cvt_pk_bf16(acc[0][bj][m][0][0], acc[0][bj][m][0][1]); w.y = cvt_pk_bf16(acc[0][bj][m][0][2], acc[0][bj][m][0][3]); w.z = cvt_pk_bf16(acc[0][bj][m][1][0], acc[0][bj][m][1][1]); w.w = cvt_pk_bf16(acc[0][bj][m][1][2], acc[0][bj][m][1][3]);
                            *(u32x4*)(HALO + ((size_t)hent * 6 + m) * 3072 + cg) = w; }
                    }
                    if (fr == 15) {
#pragma unroll
                        for (int m = 1; m < 4; ++m) { u32x4 w; w.x = cvt_pk_bf16(acc[1][bj][m][0][0], acc[1][bj][m][0][1]); w.y = cvt_pk_bf16(acc[1][bj][m][0][2], acc[1][bj][m][0][3]); w.z = cvt_pk_bf16(acc[1][bj][m][1][0], acc[1][bj][m][1][1]); w.w = cvt_pk_bf16(acc[1][bj][m][1][2], acc[1][bj][m][1][3]);
                            *(u32x4*)(HALO + ((size_t)hent * 6 + 2 + m) * 3072 + cg) = w;
                            if ((run & 15) == 15) { float* f = out + O_CP + ((size_t)(run >> 4) * 3 + (m - 1)) * 3072 + cg; *(f32x4*)f = acc[1][bj][m][0]; *(f32x4*)(f + 4) = acc[1][bj][m][1]; } }
                    }
                }
                const size_t xr0 = (size_t)((rbase >> 11) * XROWS + 8 + (rbase & (SEQ - 1)));
                typedef unsigned u32x2e __attribute__((ext_vector_type(2)));
                u32x2e keep[8];
#pragma unroll
                for (int st = 0; st < 4; ++st) {
                    const int bj = st >> 1, n = st & 1, cg = cg0 + 128 * bj;
                    if (st < 3) { const int cn = cg0 + 128 * ((st + 1) >> 1) + 4 * ((st + 1) & 1); bn_ = *(const f32x4*)(cb + cn);
#pragma unroll
                        for (int j = 0; j < 4; ++j) wn_[j] = *(const f32x4*)(cw + j * 3072 + cn); }
                    const f32x4 h3 = dpp_shr1(acc[1][bj][1][n]), h2 = dpp_shr1(acc[1][bj][2][n]), h1 = dpp_shr1(acc[1][bj][3][n]);
#pragma unroll
                    for (int idx = 0; idx < 8; ++idx) {
                        const f32x4 v0 = acc[idx >> 2][bj][idx & 3][n];
                        const f32x4 v1 = idx >= 1 ? acc[(idx - 1) >> 2][bj][(idx - 1) & 3][n] : h1;
                        const f32x4 v2 = idx >= 2 ? acc[(idx - 2) >> 2][bj][(idx - 2) & 3][n] : (idx == 1 ? h1 : h2);
                        const f32x4 v3 = idx >= 3 ? acc[(idx - 3) >> 2][bj][(idx - 3) & 3][n] : (idx == 2 ? h1 : (idx == 1 ? h2 : h3));
                        f32x4 x = bc_ + wc_[3] * v0 + wc_[2] * v1 + wc_[1] * v2 + wc_[0] * v3;
                        x = silu4_(x);
                        u32x2e w; w.x = cvt_pk_bf16(x[0], x[1]); w.y = cvt_pk_bf16(x[2], x[3]);
                        if (n == 0) keep[idx] = w; else { const u32x4 w4 = {keep[idx].x, keep[idx].y, w.x, w.y}; *(u32x4*)(XBC + (xr0 + idx) * 3072 + cg) = w4; }
                    }
                    bc_ = bn_;
#pragma unroll
                    for (int j = 0; j < 4; ++j) wc_[j] = wn_[j];
                }
            }
        } else {
            const int kind = pn == 5 ? 0 : (pn < 14 ? 1 : 3);
            bf16_t* base; int ld, c0;
            if (kind == 0) { base = Vb; ld = 256; c0 = 0; } else if (kind == 1) { base = ZS; ld = 2048; c0 = (pn - 6) * 256; } else { base = GT; ld = 2048; c0 = (pn - 26) * 256; }
            c0 += wc * 32 + 8 * fq;
#pragma unroll
            for (int ai = 0; ai < 2; ++ai) {
#pragma unroll
                for (int m = 0; m < 4; ++m) {
                    const int r = rbase + 4 * ai + m;
                    float* fo = nullptr;
                    if (kind == 0) {
                        if (r >= MP) fo = out + O_VS + ((size_t)(r - MP) * 128 + 127) * 256;
                        else if ((r & (SEQ - 1)) >= SEQ - WIN) fo = out + O_VP + ((size_t)(r >> 11) * 128 + ((r & (SEQ - 1)) - (SEQ - WIN))) * 256;
                    }
#pragma unroll
                    for (int bj = 0; bj < 2; ++bj) {
                        f32x4 v0 = acc[ai][bj][m][0], v1 = acc[ai][bj][m][1];
                        if (fo) { float* f = fo + c0 + 128 * bj; *(f32x4*)f = v0; *(f32x4*)(f + 4) = v1; }
                        if (kind == 1) {
                            v0 = silu4_(v0); v1 = silu4_(v1);
                        } else if (kind == 3) {
                            v0 = sigmoid4_(v0); v1 = sigmoid4_(v1);
                        }
                        u32x4 w; w.x = cvt_pk_bf16(v0[0], v0[1]); w.y = cvt_pk_bf16(v0[2], v0[3]); w.z = cvt_pk_bf16(v1[0], v1[1]); w.w = cvt_pk_bf16(v1[2], v1[3]);
                        *(u32x4*)(base + (size_t)r * ld + c0 + 128 * bj) = w;
                    }
                }
            }
        }
    }
};

constexpr int R2_OFF = RING_BYTES;
struct EpiMixF {
    static constexpr bool PERM = true, AFTER_DRAIN = false; static constexpr int PID = 3; static constexpr int MIDT = 16;
    const bf16_t* GT; bf16_t* MIX; const LAS float* R2L;
    __device__ __forceinline__ void mid(f32x4 (&acc)[2][2][4][2], const Unit& u, int wr, int wc, int fr, int fq) const {
        asm volatile("" : "+v"(fr), "+v"(fq));
        constexpr int PD = 4;
        const int c0 = u.pn * 256 + wc * 32 + 8 * fq;
#define MIX_ROW(s_) (((s_) >> 3) * 128 + wr * 64 + (((s_) >> 1) & 3) * 16 + fr)
#define MIX_GP(s_) (GT + (size_t)(u.pm * 256 + MIX_ROW(s_)) * 2048 + c0 + 128 * ((s_) & 1))
        u32x4 gaq[PD], gsq[PD];
#pragma unroll
        for (int st = 0; st < PD; ++st) { gaq[st] = *(const u32x4*)MIX_GP(st); gsq[st] = *(const u32x4*)(MIX_GP(st) + 1024); }
#pragma unroll
        for (int st = 0; st < 16; ++st) {
            const int ai = st >> 3, m = (st >> 1) & 3, bj = st & 1;
            const float ir2 = R2L[256 + MIX_ROW(st)];
            const u32x4 ga = gaq[st % PD], gs = gsq[st % PD];
            if (st + PD < 16) { gaq[st % PD] = *(const u32x4*)MIX_GP(st + PD); gsq[st % PD] = *(const u32x4*)(MIX_GP(st + PD) + 1024); }
            const f32x4 ga0 = {bflo(ga.x), bfhi(ga.x), bflo(ga.y), bfhi(ga.y)}, ga1 = {bflo(ga.z), bfhi(ga.z), bflo(ga.w), bfhi(ga.w)};
            const f32x4 rg0 = {frcp_(bflo(gs.x)), frcp_(bfhi(gs.x)), frcp_(bflo(gs.y)), frcp_(bfhi(gs.y))}, rg1 = {frcp_(bflo(gs.z)), frcp_(bfhi(gs.z)), frcp_(bflo(gs.w)), frcp_(bfhi(gs.w))};
            acc[ai][bj][m][0] = acc[ai][bj][m][0] * ((ga0 * ir2) * rg0); acc[ai][bj][m][1] = acc[ai][bj][m][1] * ((ga1 * ir2) * rg1);
        }
    }
    __device__ __forceinline__ void operator()(const f32x4 (&acc)[2][2][4][2], const Unit& u, int wr, int wc, int fr, int fq) const {
        asm volatile("" : "+v"(fr), "+v"(fq));
        constexpr int PD = 8;
        const int c0 = u.pn * 256 + wc * 32 + 8 * fq;
        u32x4 gsq[PD];
#pragma unroll
        for (int st = 0; st < PD; ++st) gsq[st] = *(const u32x4*)(MIX_GP(st) + 1024);
#pragma unroll
        for (int st = 0; st < 16; ++st) {
            const int ai = st >> 3, m = (st >> 1) & 3, bj = st & 1;
            const int r = u.pm * 256 + MIX_ROW(st), c = c0 + 128 * bj;
            const float r2 = R2L[MIX_ROW(st)];
            const u32x4 gs = gsq[st % PD];
            if (st + PD < 16) gsq[st % PD] = *(const u32x4*)(MIX_GP(st + PD) + 1024);
            const f32x4 g0 = {bflo(gs.x), bfhi(gs.x), bflo(gs.y), bfhi(gs.y)}, g1 = {bflo(gs.z), bfhi(gs.z), bflo(gs.w), bfhi(gs.w)};
            const f32x4 v0 = (acc[ai][bj][m][0] * r2) * g0, v1 = (acc[ai][bj][m][1] * r2) * g1;
            u32x4 w; w.x = cvt_pk_bf16(v0[0], v0[1]); w.y = cvt_pk_bf16(v0[2], v0[3]); w.z = cvt_pk_bf16(v1[0], v1[1]); w.w = cvt_pk_bf16(v1[2], v1[3]);
            *(u32x4*)(MIX + (size_t)r * 1024 + c) = w;
        }
#undef MIX_ROW
#undef MIX_GP
    }
};
struct EpiRes1 {
    static constexpr bool PERM = true, AFTER_DRAIN = false; static constexpr int PID = 4; static constexpr int MIDT = 0;
    const float* xp; const float* xs; float* out; bf16_t* X1B; float* SSQ3;
    __device__ __forceinline__ void operator()(const f32x4 (&acc)[2][2][4][2], const Unit& u, int wr, int wc, int fr, int fq) const {
        asm volatile("" : "+v"(fr), "+v"(fq));
        constexpr int PD = 8;
        const int c0 = u.pn * 256 + wc * 32 + 8 * fq;
        f32x4 xa[PD], xb[PD];
#define RES1_PTR(s_) ((((u.pm * 256 + ((s_) >> 3) * 128 + wr * 64 + (((s_) >> 1) & 3) * 16 + fr) < MP) ? xp + (size_t)(u.pm * 256 + ((s_) >> 3) * 128 + wr * 64 + (((s_) >> 1) & 3) * 16 + fr) * 1024 \
                                                                                                          : xs + (size_t)(u.pm * 256 + ((s_) >> 3) * 128 + wr * 64 + (((s_) >> 1) & 3) * 16 + fr - MP) * 1024) + c0 + 128 * ((s_) & 1))
#pragma unroll
        for (int st = 0; st < PD; ++st) { const float* xr = RES1_PTR(st); xa[st] = *(const f32x4*)xr; xb[st] = *(const f32x4*)(xr + 4); }
        float ss = 0.f;
#pragma unroll
        for (int st = 0; st < 16; ++st) {
            const int ai = st >> 3, m = (st >> 1) & 3, bj = st & 1;
            const int r = u.pm * 256 + ai * 128 + wr * 64 + m * 16 + fr, c = c0 + 128 * bj;
            const f32x4 v0 = acc[ai][bj][m][0] + xa[st % PD], v1 = acc[ai][bj][m][1] + xb[st % PD];
            if (st + PD < 16) { const float* xr = RES1_PTR(st + PD); xa[st % PD] = *(const f32x4*)xr; xb[st % PD] = *(const f32x4*)(xr + 4); }
            ss += (v0[0] * v0[0] + v0[1] * v0[1]) + (v0[2] * v0[2] + v0[3] * v0[3]) + (v1[0] * v1[0] + v1[1] * v1[1]) + (v1[2] * v1[2] + v1[3] * v1[3]);
            u32x4 w; w.x = cvt_pk_bf16(v0[0], v0[1]); w.y = cvt_pk_bf16(v0[2], v0[3]); w.z = cvt_pk_bf16(v1[0], v1[1]); w.w = cvt_pk_bf16(v1[2], v1[3]);
            *(u32x4*)(X1B + (size_t)r * 1024 + c) = w;
            if (bj == 1) { ss = sum_fq(ss); if (fq == 0) SSQ3[(size_t)r * 16 + u.pn * 4 + wc] = ss; ss = 0.f; }
        }
#undef RES1_PTR
    }
};
struct EpiUp {
    static constexpr bool PERM = true, AFTER_DRAIN = false; static constexpr int PID = 5; static constexpr int MIDT = 0;
    const float* SSQ3; bf16_t* ACT;
    __device__ __forceinline__ void operator()(const f32x4 (&acc)[2][2][4][2], const Unit& u, int wr, int wc, int fr, int fq) const {
        asm volatile("" : "+v"(fr), "+v"(fq));
        f32x4 pp[2][4];
#pragma unroll
        for (int ai = 0; ai < 2; ++ai)
#pragma unroll
            for (int m = 0; m < 4; ++m) pp[ai][m] = *(const f32x4*)(SSQ3 + (size_t)(u.pm * 256 + ai * 128 + wr * 64 + m * 16 + fr) * 16 + 4 * fq);
#pragma unroll
        for (int ai = 0; ai < 2; ++ai)
#pragma unroll
            for (int m = 0; m < 4; ++m) {
                const int r = u.pm * 256 + ai * 128 + wr * 64 + m * 16 + fr;
                const f32x4 p = pp[ai][m];
                float ss = (p[0] + p[1]) + (p[2] + p[3]);
                ss = sum_fq(ss);
                const float r3 = frsq_(ss * (1.0f / 1024.0f) + EPS);
#pragma unroll
                for (int bj = 0; bj < 2; ++bj) {
                    const int c = u.pn * 256 + 128 * bj + wc * 32 + 8 * fq;
                    f32x4 v0 = acc[ai][bj][m][0] * r3, v1 = acc[ai][bj][m][1] * r3;
#pragma unroll
                    for (int e = 0; e < 4; ++e) { v0[e] = fmaxf(v0[e], 0.f); v1[e] = fmaxf(v1[e], 0.f); }
                    v0 = v0 * v0; v1 = v1 * v1;
                    u32x4 w; w.x = cvt_pk_bf16(v0[0], v0[1]); w.y = cvt_pk_bf16(v0[2], v0[3]); w.z = cvt_pk_bf16(v1[0], v1[1]); w.w = cvt_pk_bf16(v1[2], v1[3]);
                    *(u32x4*)(ACT + (size_t)r * 4096 + c) = w;
                }
            }
    }
};
struct EpiDown {
    static constexpr bool PERM = true, AFTER_DRAIN = false; static constexpr int PID = 6; static constexpr int MIDT = 0;
    const bf16_t* X1B; float* out;
    __device__ __forceinline__ void operator()(const f32x4 (&acc)[2][2][4][2], const Unit& u, int wr, int wc, int fr, int fq) const {
        asm volatile("" : "+v"(fr), "+v"(fq));
        const int c0 = u.pn * 256 + wc * 32 + 8 * fq;
        constexpr int PD = 8;
        u32x4 xw[PD];
#define DOWN_PTR(s_) (X1B + (size_t)(u.pm * 256 + ((s_) >> 3) * 128 + wr * 64 + (((s_) >> 1) & 3) * 16 + fr) * 1024 + c0 + 128 * ((s_) & 1))
#pragma unroll
        for (int st = 0; st < PD; ++st) xw[st] = *(const u32x4*)DOWN_PTR(st);
#pragma unroll
        for (int st = 0; st < 16; ++st) {
            const int ai = st >> 3, m = (st >> 1) & 3, bj = st & 1;
            const int r = u.pm * 256 + ai * 128 + wr * 64 + m * 16 + fr, c = c0 + 128 * bj;
            const u32x4 x = xw[st % PD];
            f32x4 v0 = acc[ai][bj][m][0], v1 = acc[ai][bj][m][1];
            v0[0] += bflo(x.x); v0[1] += bfhi(x.x); v0[2] += bflo(x.y); v0[3] += bfhi(x.y); v1[0] += bflo(x.z); v1[1] += bfhi(x.z); v1[2] += bflo(x.w); v1[3] += bfhi(x.w);
            if (st + PD < 16) xw[st % PD] = *(const u32x4*)DOWN_PTR(st + PD);
            float* d = out + (size_t)r * 1024 + c; *(f32x4*)d = v0; *(f32x4*)(d + 4) = v1;
        }
#undef DOWN_PTR
    }
};

struct Args { const float* in[23]; float* out; unsigned char* ws; double invf[32]; int ph_lo, ph_hi; };
enum { I_XP = 0, I_XS, I_CK, I_CV, I_SC, I_SS, I_NMIX, I_WIN, I_QN, I_KN, I_SINK, I_CW, I_CB, I_DTB, I_ALOG, I_DSK, I_SNORM, I_WAO, I_WSO, I_WOUT, I_NMLP, I_WUP, I_WDN };

struct Frame {
    LAS unsigned char* lds;
    int wave, vcu, G;
};

__device__ __forceinline__ float wave_sum(float v) {
#pragma unroll
    for (int o = 1; o < 64; o <<= 1) v += __shfl_xor(v, o);
    return v;
}
__device__ __forceinline__ float wave_max(float v) {
#pragma unroll
    for (int o = 1; o < 64; o <<= 1) v = fmaxf(v, __shfl_xor(v, o));
    return v;
}

struct P0Item { const float* W; const float* gain; bf16* WT; int K, N, prow0, k0, n0; };
__device__ __forceinline__ void p0_item_load(const P0Item& t, f32x4 (&v)[8], float (&gk)[8], int lane) {
#pragma unroll
    for (int i = 0; i < 8; ++i) { const int kk = (lane >> 3) + 8 * i; v[i] = *(const f32x4*)(t.W + (size_t)(t.k0 + kk) * t.N + t.n0 + 4 * (lane & 7)); gk[i] = t.gain ? t.gain[t.k0 + kk] : 1.0f; }
}
__device__ __forceinline__ void p0_item_finish(const P0Item& t, const f32x4 (&v)[8], const float (&gk)[8], LAS float* scr, int lane) {
#pragma unroll
    for (int i = 0; i < 8; ++i) { const int kk = (lane >> 3) + 8 * i; LAS float* d = scr + kk * 33 + 4 * (lane & 7); d[0] = v[i][0] * gk[i]; d[1] = v[i][1] * gk[i]; d[2] = v[i][2] * gk[i]; d[3] = v[i][3] * gk[i]; }
    LDS_WAIT(); asm volatile("" ::: "memory");
    const int c = lane & 7;
#pragma unroll
    for (int j = 0; j < 4; ++j) { const int n = (lane >> 3) + 8 * j; const LAS float* s = scr + (8 * c) * 33 + n;
        v4u o; o.x = pk2(s[0 * 33], s[1 * 33]); o.y = pk2(s[2 * 33], s[3 * 33]); o.z = pk2(s[4 * 33], s[5 * 33]); o.w = pk2(s[6 * 33], s[7 * 33]);
        *(GAS v4u*)(t.WT + (size_t)(t.prow0 + n) * t.K + t.k0 + 8 * c) = o; }
    LDS_WAIT(); asm volatile("" ::: "memory");
}
__device__ __forceinline__ int win_phys_row(int n0) {
    if (n0 < 1280) { const int tile = n0 >> 8, within = n0 & 255, hh = within >> 6, half = (within & 63) >> 5; return tile * 256 + 128 * half + 32 * hh; }
    if (n0 < 6656) return n0;
    if (n0 < 6688) return 8704 + (n0 - 6656);
    return n0 - 32;
}

__device__ __forceinline__ void p0_prologue(Frame& F0, const Args& a) {
    struct { LAS unsigned char* lds; int tid, lane, wave, vcu, G; } F;
    F.lds = F0.lds; F.wave = F0.wave; F.vcu = F0.vcu; F.G = F0.G; F.lane = (int)__builtin_amdgcn_mbcnt_hi(~0u, __builtin_amdgcn_mbcnt_lo(~0u, 0u)); F.tid = F.wave * 64 + F.lane;
    unsigned char* ws = a.ws;
    LAS float* scr = (LAS float*)(F.lds + RING_OFF + F.wave * 16384);
    const int gw = F.vcu * NWAVES + F.wave, NGW = F.G * NWAVES;
    constexpr int I_1 = 16 * 273, I_A = 16 * 32, I_S = 32 * 32, I_O = 16 * 32, I_U = 16 * 128, I_D = 64 * 32;
    constexpr int NITEMS = I_1 + I_A + I_S + I_O + I_U + I_D;
    auto decode = [&](int it, P0Item& t) {
        int r = it;
        if (r < I_1) { const int kb = r / 273, nb = r % 273; t = P0Item{a.in[I_WIN], a.in[I_NMIX], (bf16*)(ws + WS_WT1), 1024, 8736, win_phys_row(nb * 32), kb * 64, nb * 32}; return; } r -= I_1;
        if (r < I_A) { const int kb = r / 32, nb = r % 32; t = P0Item{a.in[I_WAO], nullptr, (bf16*)(ws + WS_WTA), 3072, 1024, nb * 32, kb * 64, nb * 32}; return; } r -= I_A;
        if (r < I_S) { const int kb = r / 32, nb = r % 32; t = P0Item{a.in[I_WSO], a.in[I_SNORM], (bf16*)(ws + WS_WTA) + 1024, 3072, 1024, nb * 32, kb * 64, nb * 32}; return; } r -= I_S;
        if (r < I_O) { const int kb = r / 32, nb = r % 32; t = P0Item{a.in[I_WOUT], nullptr, (bf16*)(ws + WS_WTO), 1024, 1024, nb * 32, kb * 64, nb * 32}; return; } r -= I_O;
        if (r < I_U) { const int kb = r / 128, nb = r % 128; t = P0Item{a.in[I_WUP], a.in[I_NMLP], (bf16*)(ws + WS_WTU), 1024, 4096, nb * 32, kb * 64, nb * 32}; return; } r -= I_U;
        { const int kb = r / 32, nb = r % 32; t = P0Item{a.in[I_WDN], nullptr, (bf16*)(ws + WS_WTD), 4096, 1024, nb * 32, kb * 64, nb * 32}; }
    };
    P_BEGIN(31, F.lds, F.wave);
    for (int it = gw; it < NITEMS; it += 2 * NGW) {
        P0Item t0, t1; f32x4 v0[8], v1[8]; float g0[8], g1[8];
        const bool two = it + NGW < NITEMS;
        decode(it, t0); decode(two ? it + NGW : it, t1);
        p0_item_load(t0, v0, g0, F.lane); p0_item_load(t1, v1, g1, F.lane);
        p0_item_finish(t0, v0, g0, scr, F.lane);
        if (two) p0_item_finish(t1, v1, g1, scr, F.lane);
    }
    P_END(31, F.lds, F.wave); P_BEGIN(32, F.lds, F.wave);
    bf16* XB = (bf16*)(ws + WS_XB);
    for (int m0 = 4 * gw; m0 < MPAD; m0 += 4 * NGW) {
        f32x4 v[4][4];
#pragma unroll
        for (int q = 0; q < 4; ++q) {
            const int m = m0 + q, mc = m < MTOK ? m : 0;
            const float* xrow = mc < MP ? a.in[I_XP] + (size_t)mc * 1024 : a.in[I_XS] + (size_t)(mc - MP) * 1024;
            const GAS f32x4* xr = (const GAS f32x4*)xrow + F.lane;
#pragma unroll
            for (int j = 0; j < 4; ++j) v[q][j] = xr[64 * j];
        }
#pragma unroll
        for (int q = 0; q < 4; ++q) {
            const int m = m0 + q;
            float s = 0.f;
#pragma unroll
            for (int j = 0; j < 4; ++j) s += (v[q][j].x * v[q][j].x + v[q][j].y * v[q][j].y) + (v[q][j].z * v[q][j].z + v[q][j].w * v[q][j].w);
            const float rstd = m < MTOK ? frsq_(wave_sum(s) * (1.f / 1024.f) + EPS) : 0.f;
            if (m < MPAD) {
                GAS unsigned long long* o8 = (GAS unsigned long long*)(XB + (size_t)m * 1024) + F.lane;
#pragma unroll
                for (int j = 0; j < 4; ++j) o8[64 * j] = (unsigned long long)pk2(v[q][j].x * rstd, v[q][j].y * rstd) | ((unsigned long long)pk2(v[q][j].z * rstd, v[q][j].w * rstd) << 32);
            }
        }
    }
    P_END(32, F.lds, F.wave); P_BEGIN(33, F.lds, F.wave);
    const int gt = F.vcu * (NWAVES * 64) + F.tid, NGT = F.G * NWAVES * 64;
    float* rope = (float*)(ws + WS_ROPE);
    for (int e = gt; e < 2049 * 32; e += NGT) {
        const int t = e >> 5, i = e & 31;
        const double ang = (double)(t == 2048 ? 8192 : t) * a.invf[i];
        const double q = rint(ang * 0.63661977236758134308);
        double rr = fma(-q, 1.57079632679489655800, ang); rr = fma(-q, 6.12323399573676603587e-17, rr);
        const double r2 = rr * rr;
        const double sn = rr * (1.0 + r2 * (-1.0 / 6 + r2 * (1.0 / 120 + r2 * (-1.0 / 5040 + r2 * (1.0 / 362880 + r2 * (-1.0 / 39916800 + r2 * (1.0 / 6227020800.0)))))));
        const double cs = 1.0 + r2 * (-0.5 + r2 * (1.0 / 24 + r2 * (-1.0 / 720 + r2 * (1.0 / 40320 + r2 * (-1.0 / 3628800 + r2 * (1.0 / 479001600 + r2 * (-1.0 / 87178291200.0)))))));
        const int qi = ((int)q) & 3;
        const double s = (qi == 0) ? sn : (qi == 1) ? cs : (qi == 2) ? -sn : -cs;
        const double c = (qi == 0) ? cs : (qi == 1) ? -sn : (qi == 2) ? -cs : sn;
        rope[(size_t)t * 64 + i] = (float)c; rope[(size_t)t * 64 + 32 + i] = (float)s;
    }
    P_END(33, F.lds, F.wave); P_BEGIN(34, F.lds, F.wave);
    { u32x4* xz = (u32x4*)(ws + WS_XBC); for (int e = gt; e < NB * 8 * 384; e += NGT) { const int bb = e / (8 * 384), rem = e % (8 * 384); xz[(size_t)bb * XROWS * 384 + rem] = (u32x4){0u, 0u, 0u, 0u}; } }
    { u32x4* hz = (u32x4*)(ws + WS_HALO); for (int e = gt; e < NB * 6 * 384; e += NGT) { const int bb = e / (6 * 384), rem = e % (6 * 384); hz[(size_t)bb * 17 * 6 * 384 + rem] = (u32x4){0u, 0u, 0u, 0u}; } }
    {
        const f32x4* sc = (const f32x4*)a.in[I_SC]; f32x4* cs = (f32x4*)(a.out + O_CS);
        for (int e = gt; e < 128 * 2 * 768; e += NGT) { const int b = e / (2 * 768), rem = e % (2 * 768); cs[(size_t)b * 3 * 768 + rem] = sc[(size_t)b * 3 * 768 + 768 + rem]; }
    }    P_END(34, F.lds, F.wave);
}

template <bool DECODE>
__device__ __forceinline__ void attn_simple(Frame& F, const Args& a) {
    unsigned char* ws = a.ws;
    const bf16* Q = (const bf16*)(ws + WS_Q); const bf16* Kb = (const bf16*)(ws + WS_K); const bf16* Vb = (const bf16*)(ws + WS_V); bf16* OA = (bf16*)(ws + WS_OA);
    const float* sinks = a.in[I_SINK];
    int tid_ = F.wave * 64 + (int)__builtin_amdgcn_mbcnt_hi(~0u, __builtin_amdgcn_mbcnt_lo(~0u, 0u)); asm volatile("" : "+v"(tid_));
    const int lane = tid_ & 63, gw = F.vcu * NWAVES + __builtin_amdgcn_readfirstlane(tid_ >> 6), NGW = F.G * NWAVES;
    const int ntask = (DECODE ? DEC : MP) * NH;
    constexpr int DK_RS = 272, DK_TILE = 128 * DK_RS;
    if (DECODE) {
        const int rrb = F.vcu >> 1, kv0 = (F.vcu & 1) * 2;
        const float* ckr = a.in[I_CK] + (size_t)rrb * 128 * 256; float* ksr = a.out + O_KS + (size_t)rrb * 128 * 256;
        f32x4 st[8];
#pragma unroll
        for (int i = 0; i < 8; ++i) { const int f = i * 512 + tid_, tile = f >> 11, key = (f >> 4) & 127, piece = f & 15;
            const float* src = (key < 127 ? ckr + (size_t)(key + 1) * 256 : ksr + (size_t)127 * 256) + (kv0 + tile) * 64 + piece * 4;
            st[i] = *(const f32x4*)src; }
#pragma unroll
        for (int i = 0; i < 8; ++i) { const int f = i * 512 + tid_, tile = f >> 11, key = (f >> 4) & 127, piece = f & 15;
            *(LAS f32x4*)(F.lds + tile * DK_TILE + key * DK_RS + piece * 16) = st[i];
            *(f32x4*)(ksr + (size_t)key * 256 + (kv0 + tile) * 64 + piece * 4) = st[i]; }
        __syncthreads();
    }
    for (int task = gw; task < ntask; task += NGW) {
        const int rr = task >> 4, h = task & 15, kvh = h >> 2;
        const int r = DECODE ? MP + rr : rr;
        u32x4 qw[8];
        {
            const u32x4* qp = (const u32x4*)(Q + (size_t)r * 1024 + h * 64);
#pragma unroll
            for (int c = 0; c < 8; ++c) qw[c] = qp[c];
        }
#define QV(i_) (((i_) & 1) ? bfhi(qw[(i_) >> 3][((i_) >> 1) & 3]) : bflo(qw[(i_) >> 3][((i_) >> 1) & 3]))
        float sA, sB;
        if (DECODE) {
            const LAS unsigned char* kt = F.lds + (kvh & 1) * DK_TILE;
            const LAS f32x4* k0 = (const LAS f32x4*)(kt + lane * DK_RS); const LAS f32x4* k1 = (const LAS f32x4*)(kt + (lane + 64) * DK_RS);
            float s0 = 0.f, s1 = 0.f;
#pragma unroll
            for (int c = 0; c < 16; ++c) { const f32x4 x = k0[c], y = k1[c]; const float q0 = QV(4 * c), q1 = QV(4 * c + 1), q2 = QV(4 * c + 2), q3 = QV(4 * c + 3);
                s0 += q0 * x[0] + q1 * x[1] + q2 * x[2] + q3 * x[3]; s1 += q0 * y[0] + q1 * y[1] + q2 * y[2] + q3 * y[3]; }
            sA = s0; sB = s1;
        } else {
            const int b = r >> 11, t = r & (SEQ - 1);
            const int kA = t - 127 + lane, kB = t - 63 + lane;
            const int rA = b * SEQ + (kA < 0 ? 0 : kA), rB = b * SEQ + (kB < 0 ? 0 : kB);
            const u32x4* pA = (const u32x4*)(Kb + (size_t)rA * 256 + kvh * 64); const u32x4* pB = (const u32x4*)(Kb + (size_t)rB * 256 + kvh * 64);
            float s0 = 0.f, s1 = 0.f;
#pragma unroll
            for (int c = 0; c < 8; ++c) { const u32x4 x = pA[c], y = pB[c];
                s0 += QV(8 * c) * bflo(x.x) + QV(8 * c + 1) * bfhi(x.x) + QV(8 * c + 2) * bflo(x.y) + QV(8 * c + 3) * bfhi(x.y) + QV(8 * c + 4) * bflo(x.z) + QV(8 * c + 5) * bfhi(x.z) + QV(8 * c + 6) * bflo(x.w) + QV(8 * c + 7) * bfhi(x.w);
                s1 += QV(8 * c) * bflo(y.x) + QV(8 * c + 1) * bfhi(y.x) + QV(8 * c + 2) * bflo(y.y) + QV(8 * c + 3) * bfhi(y.y) + QV(8 * c + 4) * bflo(y.z) + QV(8 * c + 5) * bfhi(y.z) + QV(8 * c + 6) * bflo(y.w) + QV(8 * c + 7) * bfhi(y.w); }
            sA = kA < 0 ? -INFINITY : s0; sB = kB < 0 ? -INFINITY : s1;
        }
        const float sink = sinks[h] * 1.4426950408889634f;
        const float mx = fmaxf(wave_max(fmaxf(sA, sB)), sink);
        float pA_ = __builtin_amdgcn_exp2f(sA - mx), pB_ = __builtin_amdgcn_exp2f(sB - mx);
        const float den = wave_sum(pA_ + pB_) + __builtin_amdgcn_exp2f(sink - mx);
        const float inv = frcp_(den); pA_ *= inv; pB_ *= inv;
        float o = 0.f;
        if (DECODE) {
            const float* cvb = a.in[I_CV] + (size_t)rr * 128 * 256 + kvh * 64 + lane; float* vsb = a.out + O_VS + (size_t)rr * 128 * 256 + kvh * 64 + lane;
            const bool cpv = (h & 3) == 0;
            float va[64], vb[64];
#pragma unroll
            for (int j = 0; j < 64; ++j) { va[j] = cvb[(size_t)(j + 1) * 256]; vb[j] = j < 63 ? cvb[(size_t)(j + 65) * 256] : vsb[(size_t)127 * 256]; }
#pragma unroll
            for (int j = 0; j < 64; ++j) { const float pa = __int_as_float(__builtin_amdgcn_readlane(__float_as_int(pA_), j)), pb = __int_as_float(__builtin_amdgcn_readlane(__float_as_int(pB_), j)); o += pa * va[j] + pb * vb[j]; }
            if (cpv) {
#pragma unroll
                for (int j = 0; j < 64; ++j) { vsb[(size_t)j * 256] = va[j]; vsb[(size_t)(j + 64) * 256] = vb[j]; }
            }
        } else {
            const int b = r >> 11, t = r & (SEQ - 1);
            for (int j = 0; j < 64; ++j) { const float pa = __shfl(pA_, j), pb = __shfl(pB_, j);
                const int kA = t - 127 + j, kB = t - 63 + j; const int rA = b * SEQ + (kA < 0 ? 0 : kA), rB = b * SEQ + (kB < 0 ? 0 : kB);
                o += pa * bf2f(Vb[(size_t)rA * 256 + kvh * 64 + lane]) + pb * bf2f(Vb[(size_t)rB * 256 + kvh * 64 + lane]); }
        }
        OA[(size_t)r * 3072 + h * 64 + lane] = (bf16)f2bf(o);
    }
}

__device__ __forceinline__ void ssd_simple_prompt(Frame& F, const Args& a) {
    unsigned char* ws = a.ws;
    const bf16* XBC = (const bf16*)(ws + WS_XBC); const bf16* ZS = (const bf16*)(ws + WS_ZS); const float* DT = (const float*)(ws + WS_DT);
    bf16* YZ = (bf16*)(ws + WS_YZ); float* SSQ2 = (float*)(ws + WS_SSQ2);
    const float* cw = a.in[I_CW]; const float* cb = a.in[I_CB];
    LAS float* xs = (LAS float*)(F.lds);
    LAS float* Bs = xs + 64 * 64;
    LAS float* Cs = Bs + 64 * 128;
    LAS float* zs = Cs + 64 * 128;
    LAS float* ys = zs + 64 * 64;
    LAS float* dts = ys + 64 * 64;
    const int tid = F.wave * 64 + (int)__builtin_amdgcn_mbcnt_hi(~0u, __builtin_amdgcn_mbcnt_lo(~0u, 0u)), p = tid >> 3, nq = tid & 7;
    for (int item = F.vcu; item < NB * SH; item += F.G) {
        const int b = item >> 5, hh = item & 31, g = hh >> 3;
        const float A = -__expf(a.in[I_ALOG][hh]), Dk = a.in[I_DSK][hh];
        float h[16];
#pragma unroll
        for (int i = 0; i < 16; ++i) h[i] = 0.f;
        for (int t0 = 0; t0 < SEQ; t0 += 64) {
            for (int e = tid; e < 64 * 320; e += 512) {
                const int tok = e / 320, ch = e % 320;
                const int gch = ch < 64 ? hh * 64 + ch : (ch < 192 ? 2048 + g * 128 + (ch - 64) : 2560 + g * 128 + (ch - 192));
                float acc = cb[gch];
#pragma unroll
                for (int j = 0; j < 4; ++j) { const int tt = t0 + tok - 3 + j; if (tt >= 0) acc += cw[j * 3072 + gch] * bf2f(XBC[(size_t)(b * XROWS + 8 + tt) * 3072 + gch]); }
                const float v = siluf_(acc);
                if (ch < 64) xs[tok * 64 + ch] = v; else if (ch < 192) Bs[tok * 128 + ch - 64] = v; else Cs[tok * 128 + ch - 192] = v;
            }
            for (int e = tid; e < 64 * 64; e += 512) { const int tok = e >> 6, pp = e & 63; zs[e] = bf2f(ZS[(size_t)(b * SEQ + t0 + tok) * 2048 + hh * 64 + pp]); }
            if (tid < 64) dts[tid] = DT[(size_t)(b * SEQ + t0 + tid) * 32 + hh];
            __syncthreads();
            for (int tok = 0; tok < 64; ++tok) {
                const float dt = dts[tok], dA = __expf(dt * A), x = xs[tok * 64 + p], dx = dt * x;
                float y = 0.f;
#pragma unroll
                for (int i4 = 0; i4 < 4; ++i4) {
                    const f32x4 bv = *(const LAS f32x4*)(Bs + tok * 128 + nq * 16 + 4 * i4), cv = *(const LAS f32x4*)(Cs + tok * 128 + nq * 16 + 4 * i4);
#pragma unroll
                    for (int e = 0; e < 4; ++e) { h[4 * i4 + e] = dA * h[4 * i4 + e] + dx * bv[e]; y += h[4 * i4 + e] * cv[e]; }
                }
                y += __shfl_xor(y, 1); y += __shfl_xor(y, 2); y += __shfl_xor(y, 4);
                if (nq == 0) ys[tok * 64 + p] = (y + Dk * x) * zs[tok * 64 + p];
            }
            __syncthreads();
            for (int e = tid; e < 64 * 64; e += 512) { const int tok = e >> 6, pp = e & 63; YZ[(size_t)(b * SEQ + t0 + tok) * 2048 + hh * 64 + pp] = (bf16)f2bf(ys[e]); }
            if (tid < 128) { const int tok = tid >> 1, half = tid & 1; float s = 0.f;
                for (int i = 0; i < 32; ++i) { const float v = ys[tok * 64 + half * 32 + i]; s += v * v; }
                SSQ2[(size_t)(b * SEQ + t0 + tok) * 64 + hh * 2 + half] = s; }
            __syncthreads();
        }
        float* hp = a.out + O_HP + ((size_t)(b * SH + hh) * 64 + p) * 128 + nq * 16;
#pragma unroll
        for (int i4 = 0; i4 < 4; ++i4) *(f32x4*)(hp + 4 * i4) = (f32x4){h[4 * i4], h[4 * i4 + 1], h[4 * i4 + 2], h[4 * i4 + 3]};
    }
}

__device__ __forceinline__ void ssd_simple_decode(Frame& F, const Args& a) {
    unsigned char* ws = a.ws;
    const bf16* ZS = (const bf16*)(ws + WS_ZS); const float* DT = (const float*)(ws + WS_DT);
    bf16* YZ = (bf16*)(ws + WS_YZ); float* SSQ2 = (float*)(ws + WS_SSQ2);
    const float* cw = a.in[I_CW]; const float* cb = a.in[I_CB]; const float* sc = a.in[I_SC]; const float* h0 = a.in[I_SS];
    LAS float* xc = (LAS float*)(F.lds);
    LAS float* ys = xc + 320;
    int tid_ = F.wave * 64 + (int)__builtin_amdgcn_mbcnt_hi(~0u, __builtin_amdgcn_mbcnt_lo(~0u, 0u)); asm volatile("" : "+v"(tid_));
    const int tid = tid_, p = tid >> 3, nq = tid & 7;
    for (int item = F.vcu; item < DEC * SH; item += F.G) {
        const int b = item >> 5, hh = item & 31, g = hh >> 3, r = MP + b;
        if (tid < 320) {
            const int ch = tid; const int gch = ch < 64 ? hh * 64 + ch : (ch < 192 ? 2048 + g * 128 + (ch - 64) : 2560 + g * 128 + (ch - 192));
            float acc = cb[gch];
#pragma unroll
            for (int j = 0; j < 3; ++j) acc += cw[j * 3072 + gch] * sc[((size_t)b * 3 + j) * 3072 + gch];
            acc += cw[3 * 3072 + gch] * a.out[O_CS + ((size_t)b * 3 + 2) * 3072 + gch];
            xc[ch] = siluf_(acc);
        }
        __syncthreads();
        const float dt = DT[(size_t)r * 32 + hh], A = -__expf(a.in[I_ALOG][hh]), dA = __expf(dt * A), x = xc[p], dx = dt * x;
        const float* hin = h0 + ((size_t)(b * SH + hh) * 64 + p) * 128 + nq * 16;
        float* hout = a.out + O_HS + ((size_t)(b * SH + hh) * 64 + p) * 128 + nq * 16;
        float y = 0.f;
#pragma unroll
        for (int i4 = 0; i4 < 4; ++i4) {
            f32x4 hv = *(const f32x4*)(hin + 4 * i4);
#pragma unroll
            for (int e = 0; e < 4; ++e) { hv[e] = dA * hv[e] + dx * xc[64 + nq * 16 + 4 * i4 + e]; y += hv[e] * xc[192 + nq * 16 + 4 * i4 + e]; }
            *(f32x4*)(hout + 4 * i4) = hv;
        }
        y += __shfl_xor(y, 1); y += __shfl_xor(y, 2); y += __shfl_xor(y, 4);
        if (nq == 0) { const float yz = (y + a.in[I_DSK][hh] * x) * bf2f(ZS[(size_t)r * 2048 + hh * 64 + p]); ys[p] = yz; YZ[(size_t)r * 2048 + hh * 64 + p] = (bf16)f2bf(yz); }
        __syncthreads();
        if (tid < 2) { float s = 0.f; for (int i = 0; i < 32; ++i) { const float v = ys[tid * 32 + i]; s += v * v; } SSQ2[(size_t)r * 64 + hh * 2 + tid] = s; }
        __syncthreads();
    }
}


typedef float f32x16 __attribute__((ext_vector_type(16)));
typedef short bf16x8v __attribute__((ext_vector_type(8)));
typedef unsigned u32x2 __attribute__((ext_vector_type(2)));
__device__ __forceinline__ bf16x8v pack8(float a0, float a1, float a2, float a3, float a4, float a5, float a6, float a7) {
    u32x4 w; w.x = cvt_pk_bf16(a0, a1); w.y = cvt_pk_bf16(a2, a3); w.z = cvt_pk_bf16(a4, a5); w.w = cvt_pk_bf16(a6, a7);
    return __builtin_bit_cast(bf16x8v, w);
}
#define MFMA32(a, b, c) __builtin_amdgcn_mfma_f32_32x32x16_bf16((a), (b), (c), 0, 0, 0)

constexpr int AT_KS = 144, AT_VS = 520;
constexpr int AT_K_OFF = 0, AT_V_OFF = 256 * AT_KS;
__device__ __forceinline__ void attn_prompt_mfma(Frame& F, const Args& a) {
    unsigned char* ws = a.ws;
    const bf16* Q = (const bf16*)(ws + WS_Q); const bf16* Kb = (const bf16*)(ws + WS_K); const bf16* Vb = (const bf16*)(ws + WS_V); bf16* OA = (bf16*)(ws + WS_OA);
    int tid_ = F.wave * 64 + (int)__builtin_amdgcn_mbcnt_hi(~0u, __builtin_amdgcn_mbcnt_lo(~0u, 0u)); asm volatile("" : "+v"(tid_));
    const int tid = tid_, lane = tid & 63, wave = __builtin_amdgcn_readfirstlane(tid >> 6), r32 = lane & 31, hi = lane >> 5;
    LAS unsigned char* Ks = F.lds + AT_K_OFF; LAS unsigned char* VT = F.lds + AT_V_OFF;
    for (int item = F.vcu; item < NB * 16 * KVH; item += F.G) {
        const int kvh = item & 3, qblk = (item >> 2) & 15, b = item >> 6;
        const int row0 = b * SEQ + qblk * 128, krow0 = row0 - 128;
        __syncthreads();
        P_BEGIN(70, F.lds, wave);
        bf16x8v qfa[2][4];
        { const int hq_ = kvh * 4 + (wave >> 1);
#pragma unroll
          for (int bl = 0; bl < 2; ++bl)
#pragma unroll
              for (int ks = 0; ks < 4; ++ks) qfa[bl][ks] = *(const bf16x8v*)(Q + (size_t)(row0 + (wave & 1) * 64 + bl * 32 + r32) * 1024 + hq_ * 64 + ks * 16 + hi * 8); }
        {
            const int piece = tid & 7;
            u32x4 kq[4], vq[4];
#pragma unroll
            for (int i = 0; i < 4; ++i) {
                const int key = 64 * i + (tid >> 3); int grow = krow0 + key; if (qblk == 0 && key < 128) grow = row0;
                kq[i] = *((const u32x4*)(Kb + (size_t)grow * 256 + kvh * 64) + piece);
                vq[i] = *((const u32x4*)(Vb + (size_t)grow * 256 + kvh * 64) + piece);
            }
#pragma unroll
            for (int i = 0; i < 4; ++i) {
                const int key = 64 * i + (tid >> 3);
                *(LAS u32x4*)(Ks + key * AT_KS + piece * 16) = kq[i];
                LAS unsigned short* vt = (LAS unsigned short*)(VT + (piece * 8) * AT_VS + key * 2);
                const u32x4 v = vq[i];
                vt[0 * (AT_VS / 2)] = (unsigned short)(v.x & 0xffffu); vt[1 * (AT_VS / 2)] = (unsigned short)(v.x >> 16); vt[2 * (AT_VS / 2)] = (unsigned short)(v.y & 0xffffu); vt[3 * (AT_VS / 2)] = (unsigned short)(v.y >> 16);
                vt[4 * (AT_VS / 2)] = (unsigned short)(v.z & 0xffffu); vt[5 * (AT_VS / 2)] = (unsigned short)(v.z >> 16); vt[6 * (AT_VS / 2)] = (unsigned short)(v.w & 0xffffu); vt[7 * (AT_VS / 2)] = (unsigned short)(v.w >> 16);
            }
        }
        __syncthreads();
        P_END(70, F.lds, wave); P_BEGIN(71, F.lds, wave);
        const int hq = kvh * 4 + (wave >> 1);
        const float sink = a.in[I_SINK][hq] * 1.4426950408889634f;
#pragma unroll 1
        for (int blk = 0; blk < 2; ++blk) {
            const int qo = (wave & 1) * 64 + blk * 32, kt0 = qo >> 5;
            const int qrow = row0 + qo + r32, qi = qo + r32;
            bf16x8v qf[4];
#pragma unroll
            for (int ks = 0; ks < 4; ++ks) qf[ks] = blk ? qfa[1][ks] : qfa[0][ks];
            f32x16 s[5];
#pragma unroll
            for (int tt = 0; tt < 5; ++tt) {
                f32x16 acc = {};
#pragma unroll
                for (int ks = 0; ks < 4; ++ks) { const bf16x8v kf = *(const LAS bf16x8v*)(Ks + ((kt0 + tt) * 32 + r32) * AT_KS + (ks * 16 + hi * 8) * 2); acc = MFMA32(kf, qf[ks], acc); }
                s[tt] = acc;
            }
            float mx = sink;
#pragma unroll
            for (int tt = 0; tt < 5; ++tt) {
                if (tt == 0 || tt == 4 || qblk == 0) {
#pragma unroll
                    for (int r = 0; r < 16; ++r) {
                        const int j = 32 * (kt0 + tt) + (r & 3) + 8 * (r >> 2) + 4 * hi;
                        const bool ok = (j > qi) && (j <= 128 + qi) && (qblk > 0 || j >= 128);
                        s[tt][r] = ok ? s[tt][r] : -INFINITY;
                    }
                }
#pragma unroll
                for (int r = 0; r < 16; ++r) mx = fmaxf(mx, s[tt][r]);
            }
            mx = fmaxf(mx, __shfl_xor(mx, 32));
            float l = 0.f;
#pragma unroll
            for (int tt = 0; tt < 5; ++tt)
#pragma unroll
                for (int r = 0; r < 16; ++r) { const float p = __builtin_amdgcn_exp2f(s[tt][r] - mx); s[tt][r] = p; l += p; }
            l += __shfl_xor(l, 32); l += __builtin_amdgcn_exp2f(sink - mx);
            f32x16 o0 = {}, o1 = {};
#pragma unroll
            for (int tt = 0; tt < 5; ++tt)
#pragma unroll
                for (int sk = 0; sk < 2; ++sk) {
                    const bf16x8v pf = pack8(s[tt][8 * sk], s[tt][8 * sk + 1], s[tt][8 * sk + 2], s[tt][8 * sk + 3], s[tt][8 * sk + 4], s[tt][8 * sk + 5], s[tt][8 * sk + 6], s[tt][8 * sk + 7]);
                    const int kbase = 32 * (kt0 + tt) + 16 * sk + 4 * hi;
                    const LAS unsigned char* v0p = VT + r32 * AT_VS + kbase * 2; const LAS unsigned char* v1p = v0p + 32 * AT_VS;
                    const u32x2 a0 = *(const LAS u32x2*)v0p, a1 = *(const LAS u32x2*)(v0p + 16), b0 = *(const LAS u32x2*)v1p, b1 = *(const LAS u32x2*)(v1p + 16);
                    const u32x4 av = {a0.x, a0.y, a1.x, a1.y}, bv = {b0.x, b0.y, b1.x, b1.y};
                    o0 = MFMA32(__builtin_bit_cast(bf16x8v, av), pf, o0); o1 = MFMA32(__builtin_bit_cast(bf16x8v, bv), pf, o1);
                }
            const float inv = frcp_(l);
            o0 = o0 * inv; o1 = o1 * inv;
            {
                u32x2 w0[4], w1[4];
#pragma unroll
                for (int g = 0; g < 4; ++g) { w0[g].x = cvt_pk_bf16(o0[4 * g], o0[4 * g + 1]); w0[g].y = cvt_pk_bf16(o0[4 * g + 2], o0[4 * g + 3]); w1[g].x = cvt_pk_bf16(o1[4 * g], o1[4 * g + 1]); w1[g].y = cvt_pk_bf16(o1[4 * g + 2], o1[4 * g + 3]); }
                bf16* op = OA + (size_t)qrow * 3072 + hq * 64 + 16 * hi;
                { const auto s0 = __builtin_amdgcn_permlane32_swap(w0[0].x, w0[2].x, false, false), s1 = __builtin_amdgcn_permlane32_swap(w0[0].y, w0[2].y, false, false);
                  const auto s2 = __builtin_amdgcn_permlane32_swap(w0[1].x, w0[3].x, false, false), s3 = __builtin_amdgcn_permlane32_swap(w0[1].y, w0[3].y, false, false);
                  *(u32x4*)op = (u32x4){s0[0], s1[0], s0[1], s1[1]}; *(u32x4*)(op + 8) = (u32x4){s2[0], s3[0], s2[1], s3[1]}; }
                { const auto s0 = __builtin_amdgcn_permlane32_swap(w1[0].x, w1[2].x, false, false), s1 = __builtin_amdgcn_permlane32_swap(w1[0].y, w1[2].y, false, false);
                  const auto s2 = __builtin_amdgcn_permlane32_swap(w1[1].x, w1[3].x, false, false), s3 = __builtin_amdgcn_permlane32_swap(w1[1].y, w1[3].y, false, false);
                  *(u32x4*)(op + 32) = (u32x4){s0[0], s1[0], s0[1], s1[1]}; *(u32x4*)(op + 40) = (u32x4){s2[0], s3[0], s2[1], s3[1]}; }
            }
        }
        P_END(71, F.lds, wave);
    }
}

constexpr int SD_RS = 272;
constexpr int SD_XT = 0, SD_BM = SD_XT + 64 * SD_RS, SD_CM = SD_BM + 128 * SD_RS, SD_BW = SD_CM + 128 * SD_RS, SD_HB = SD_BW + 128 * SD_RS, SD_SC = SD_HB + 64 * SD_RS;
constexpr int SD_SCB = 4112, SD_WL = SD_SC + 2 * SD_SCB, SD_XD = SD_WL + 5 * 320 * 4, SD_END = SD_XD + 2 * 776 * 4;
static_assert(SD_END <= LDSCTL_OFF, "SSD LDS map");

__device__ __forceinline__ void decode_conv_to_lds(Frame& F, const Args& a) {
    unsigned char* ws = a.ws;
    const float* cw = a.in[I_CW]; const float* cb = a.in[I_CB]; const float* DT = (const float*)(ws + WS_DT);
    int tid_ = F.wave * 64 + (int)__builtin_amdgcn_mbcnt_hi(~0u, __builtin_amdgcn_mbcnt_lo(~0u, 0u)); asm volatile("" : "+v"(tid_));
    LAS unsigned char* L = F.lds;
    {
            LAS float* XD = (LAS float*)(L + SD_XD);
            const float* sc = a.in[I_SC];
#pragma unroll
            for (int it = 0; it < 2; ++it) {
                const int ditem = F.vcu + F.G * it, db = ditem >> 2, dg = ditem & 3;
#pragma unroll
                for (int q = 0; q < 2; ++q) {
                    const int e = tid_ + 512 * q;
                    if (e < 768) {
                        const int gch = e < 512 ? 512 * dg + e : (e < 640 ? 2048 + 128 * dg + (e - 512) : 2560 + 128 * dg + (e - 640));
                        float acc = cb[gch] + cw[gch] * sc[((size_t)db * 3) * 3072 + gch] + cw[3072 + gch] * sc[((size_t)db * 3 + 1) * 3072 + gch] + cw[2 * 3072 + gch] * sc[((size_t)db * 3 + 2) * 3072 + gch]
                                  + cw[3 * 3072 + gch] * a.out[O_CS + ((size_t)db * 3 + 2) * 3072 + gch];
                        XD[it * 776 + e] = siluf_(acc);
                    }
                }
                if (tid_ < 8) XD[it * 776 + 768 + tid_] = DT[(size_t)(MP + db) * 32 + 8 * dg + tid_];
            }
        }
    __syncthreads();
}

template <bool DECF>
__device__ __forceinline__ void ssd_prompt_mfma(Frame& F, const Args& a) {
    unsigned char* ws = a.ws;
    const bf16* XBC = (const bf16*)(ws + WS_XBC); const bf16* ZS = (const bf16*)(ws + WS_ZS); const float* DT = (const float*)(ws + WS_DT); const bf16* HALO = (const bf16*)(ws + WS_HALO);
    bf16* YZ = (bf16*)(ws + WS_OA) + 1024; float* SSQ2 = (float*)(ws + WS_SSQ2);
    const float* cw = a.in[I_CW]; const float* cb = a.in[I_CB];
    int tid_ = F.wave * 64 + (int)__builtin_amdgcn_mbcnt_hi(~0u, __builtin_amdgcn_mbcnt_lo(~0u, 0u)); asm volatile("" : "+v"(tid_));
    const int lane = tid_ & 63, wave = __builtin_amdgcn_readfirstlane(tid_ >> 6), r32 = lane & 31, hi = lane >> 5;
    LAS unsigned char* L = F.lds;
    for (int item = F.vcu; item < NB * SH; item += F.G) {
        const int b = item >> 5, hh = item & 31, g = hh >> 3;
        const float A = -__expf(a.in[I_ALOG][hh]), Dk = a.in[I_DSK][hh];
        const int gchB = 2048 + g * 128 + 2 * lane, gchX = hh * 64 + 2 * (lane & 31);
#define GCH(i_) ((i_) < 2 ? gchB : ((i_) < 4 ? gchB + 512 : gchX))
        const int wC = (wave + 5) & 7, wX = (wave + 3) & 7;
#define TG(i_) ((i_) < 2 ? 2 * wave + ((i_) & 1) : ((i_) < 4 ? 2 * wC + ((i_) & 1) : 2 * wX + (lane >> 5)))
        unsigned voffB = (unsigned)gchB * 2u, voffX = (unsigned)gchX * 2u + (unsigned)(lane >> 5) * 8u * 6144u, voffXh = (unsigned)gchX * 2u;
        unsigned R[5][8], HR[6]; float dn0 = 0.f, dn1 = 0.f;
        const bool fixw = (wave == 0) || (wave == 3) || (wave == 5);
#define SSD_ISSUE_LOADS(c_, lo_, hi_) do { \
            const char* cb_ = (const char*)XBC + ((size_t)(b * XROWS + 8 + (c_) * 128) * 3072) * 2; \
            _Pragma("unroll") for (int i_ = (lo_); i_ < (hi_); ++i_) { \
                const char* rb_ = cb_ + (size_t)(16 * ((i_) < 2 ? wave : ((i_) < 4 ? wC : wX))) * 6144; \
                const unsigned vo_ = (i_) < 2 ? voffB + (unsigned)((i_) & 1) * 8u * 6144u : ((i_) < 4 ? voffB + 1024u + (unsigned)((i_) & 1) * 8u * 6144u : voffX); \
                _Pragma("unroll") for (int j_ = 0; j_ < 8; ++j_) R[i_][j_] = *(const unsigned*)(rb_ + (size_t)j_ * 6144 + vo_); } \
            } while (0)
#define SSD_ISSUE_HR(c_) do { if (fixw) { \
                const char* hb_ = (const char*)HALO + ((size_t)(b * 17 + (c_)) * 6 + 3) * 6144; \
                const unsigned vo_ = wave == 0 ? voffB : (wave == 3 ? voffB + 1024u : voffXh); \
                _Pragma("unroll") for (int j_ = 0; j_ < 6; ++j_) HR[j_] = *(const unsigned*)(hb_ + (size_t)j_ * 6144 + vo_); } } while (0)
#define SSD_ISSUE_DT(c_) do { if (wave == 7) { dn0 = DT[(size_t)(b * SEQ + (c_) * 128 + 2 * lane) * 32 + hh]; dn1 = DT[(size_t)(b * SEQ + (c_) * 128 + 2 * lane + 1) * 32 + hh]; } } while (0)
        {
            LAS float* WL = (LAS float*)(L + SD_WL);
            for (int e = tid_; e < 5 * 320; e += 512) { const int j = e / 320, ch = e % 320; const int gc = ch < 64 ? hh * 64 + ch : (ch < 192 ? 2048 + g * 128 + (ch - 64) : 2560 + g * 128 + (ch - 192)); WL[e] = j < 4 ? cw[j * 3072 + gc] : cb[gc]; }
        }
        asm volatile("" ::: "memory"); __builtin_amdgcn_sched_barrier(0);
#define SCAN_DPP_(v_, ctrl_, rm_) (v_) += __builtin_bit_cast(float, __builtin_amdgcn_update_dpp(0, __builtin_bit_cast(int, (v_)), (ctrl_), (rm_), 0xf, false))
#define RDLANE_(v_, l_) __int_as_float(__builtin_amdgcn_readlane(__float_as_int(v_), (l_)))
#define SSD_SCAN(SCp_) do {   \
            const float a0 = dn0 * A, a1 = dn1 * A, ps = a0 + a1; float sc = ps; \
              \
            SCAN_DPP_(sc, 0x111, 0xf); SCAN_DPP_(sc, 0x112, 0xf); SCAN_DPP_(sc, 0x114, 0xf); SCAN_DPP_(sc, 0x118, 0xf); SCAN_DPP_(sc, 0x142, 0xa); SCAN_DPP_(sc, 0x143, 0xc); \
            const float ex = sc - ps; \
            (SCp_)[2 * lane] = ex + a0; (SCp_)[2 * lane + 1] = ex + ps; (SCp_)[128 + 2 * lane] = dn0; (SCp_)[128 + 2 * lane + 1] = dn1; } while (0)
#define SSD_SCAN2(SCp_) do { \
            const int s_ = tid_ & 127; const float cs_ = (SCp_)[s_], ds_ = (SCp_)[128 + s_]; \
            if (wave < 2) { const float cl_ = (SCp_)[127]; (SCp_)[256 + s_] = __expf(cl_ - cs_) * ds_; (SCp_)[384 + s_] = __expf(cs_); if (tid_ == 0) (SCp_)[512] = __expf(cl_); } \
            else if (wave < 4) { const float rf1_ = (SCp_)[31], rf2_ = (SCp_)[63], rf3_ = (SCp_)[95]; const int ltl_ = s_ >> 5; const float rfl_ = ltl_ == 1 ? rf1_ : (ltl_ == 2 ? rf2_ : rf3_); \
                (SCp_)[516 + s_] = __expf(fminf(cs_ - rfl_, 0.f)); (SCp_)[644 + s_] = __expf(fminf(rf1_ - cs_, 0.f)) * ds_; } \
            else if (wave < 6) { (SCp_)[772 + s_] = __expf(fminf((SCp_)[63] - cs_, 0.f)) * ds_; } \
            else { (SCp_)[900 + s_] = __expf(fminf((SCp_)[95] - cs_, 0.f)) * ds_; } } while (0)
        f32x4 hn[4] = {}; u32x4 znw = {0u, 0u, 0u, 0u}; float aln = 0.f, dkn = 0.f;
        const int dp = tid_ >> 3, dq = tid_ & 7;
#define DECS_LOAD(st_) do { const int it_ = F.vcu + F.G * ((st_) >> 3), bb_ = it_ >> 2, hh_ = 8 * (it_ & 3) + ((st_) & 7); \
            const float* hin_ = a.in[I_SS] + ((size_t)(bb_ * SH + hh_) * 64 + 8 * wave) * 128 + 4 * lane; \
            _Pragma("unroll") for (int i_ = 0; i_ < 4; ++i_) hn[i_] = *(const f32x4*)(hin_ + 256 * i_); \
            znw = *(const u32x4*)(ZS + (size_t)(MP + bb_) * 2048 + hh_ * 64 + 8 * wave); aln = a.in[I_ALOG][hh_]; dkn = a.in[I_DSK][hh_]; } while (0)
        if (DECF) { DECS_LOAD(0); }
        u32x2 zq[4]; u32x4 zwn[2];
#define SSD_ISSUE_Z(c_) do { const size_t yr_ = (size_t)(b * SEQ + (c_) * 128 + (wave >> 1) * 32 + r32); \
            const bf16* zp_ = ZS + yr_ * 2048 + hh * 64 + (wave & 1) * 32 + 16 * hi; zwn[0] = *(const u32x4*)zp_; zwn[1] = *(const u32x4*)(zp_ + 8); } while (0)
        SSD_ISSUE_Z(0);
        SSD_ISSUE_LOADS(0, 0, 2); SSD_ISSUE_HR(0); SSD_ISSUE_LOADS(0, 2, 5); SSD_ISSUE_DT(0);
        if (wave == 7) { SSD_SCAN((LAS float*)(L + SD_SC)); SSD_ISSUE_DT(1); }
        __syncthreads();
        SSD_SCAN2((LAS float*)(L + SD_SC));
        f32x16 hacc = {};
        const int nt = wave >> 1, pt = wave & 1, lt = wave >> 1;
#pragma unroll 1
        for (int c = 0; c < 16; ++c) {
            P_BEGIN(50, L, wave);
            LAS float* SC = (LAS float*)(L + SD_SC + (c & 1) * SD_SCB);
            asm volatile("" : "+v"(voffB), "+v"(voffX), "+v"(voffXh));
            __syncthreads();
            P_END(50, L, wave); P_BEGIN(51, L, wave);
            if (DECF) {
                const LAS float* XD = (const LAS float*)(L + SD_XD) + (c >> 3) * 776;
                const int ditem = F.vcu + F.G * (c >> 3), db = ditem >> 2, dhh = 8 * (ditem & 3) + (c & 7);
                const int dhalf = lane >> 5, dcq = lane & 31;
                const float ddt = XD[768 + (c & 7)], ddA = __expf(-ddt * __expf(aln));
                const f32x4 xlo = *(const LAS f32x4*)(XD + 64 * (c & 7) + 8 * wave), xhi = *(const LAS f32x4*)(XD + 64 * (c & 7) + 8 * wave + 4);
                const f32x4 bb = *(const LAS f32x4*)(XD + 512 + 4 * dcq), cc = *(const LAS f32x4*)(XD + 640 + 4 * dcq);
                float* hout = a.out + O_HS + ((size_t)(db * SH + dhh) * 64 + 8 * wave) * 128 + 4 * lane;
                float yv[4];
#pragma unroll
                for (int i = 0; i < 4; ++i) {
                    const float xe = i == 0 ? xlo[0] : (i == 1 ? xlo[2] : (i == 2 ? xhi[0] : xhi[2])), xo = i == 0 ? xlo[1] : (i == 1 ? xlo[3] : (i == 2 ? xhi[1] : xhi[3]));
                    const float x_i = dhalf ? xo : xe;
                    const f32x4 hv = hn[i] * ddA + bb * (ddt * x_i);
                    *(f32x4*)(hout + 256 * i) = hv;
                    const f32x4 pr = hv * cc;
                    float d = (pr[0] + pr[1]) + (pr[2] + pr[3]);
                    d += __builtin_bit_cast(float, __builtin_amdgcn_update_dpp(0, __builtin_bit_cast(int, d), 0xB1, 0xf, 0xf, true));
                    d += __builtin_bit_cast(float, __builtin_amdgcn_update_dpp(0, __builtin_bit_cast(int, d), 0x4E, 0xf, 0xf, true));
                    d += __builtin_bit_cast(float, __builtin_amdgcn_update_dpp(0, __builtin_bit_cast(int, d), 0x141, 0xf, 0xf, true));
                    d += __builtin_bit_cast(float, __builtin_amdgcn_update_dpp(0, __builtin_bit_cast(int, d), 0x140, 0xf, 0xf, true));
                    d += __builtin_bit_cast(float, __builtin_amdgcn_ds_swizzle(__builtin_bit_cast(int, d), 0x401F));
                    const float z_i = dhalf ? bfhi(znw[i]) : bflo(znw[i]);
                    yv[i] = (d + dkn * x_i) * z_i;
                }
                const float o0 = RDLANE_(yv[0], 32), o1 = RDLANE_(yv[1], 32), o2 = RDLANE_(yv[2], 32), o3 = RDLANE_(yv[3], 32);
                if (lane == 0) *(bf16x8v*)(YZ + (size_t)(MP + db) * 3072 + dhh * 64 + 8 * wave) = pack8(yv[0], o0, yv[1], o1, yv[2], o2, yv[3], o3);
            }
            {
                const auto s0 = __builtin_amdgcn_permlane32_swap(zwn[0].x, zwn[0].z, false, false), s1 = __builtin_amdgcn_permlane32_swap(zwn[0].y, zwn[0].w, false, false);
                const auto s2 = __builtin_amdgcn_permlane32_swap(zwn[1].x, zwn[1].z, false, false), s3 = __builtin_amdgcn_permlane32_swap(zwn[1].y, zwn[1].w, false, false);
                zq[0].x = s0[0]; zq[0].y = s1[0]; zq[2].x = s0[1]; zq[2].y = s1[1]; zq[1].x = s2[0]; zq[1].y = s3[0]; zq[3].x = s2[1]; zq[3].y = s3[1];
            }
            asm volatile("" : "+v"(zq[0].x), "+v"(zq[0].y), "+v"(zq[1].x), "+v"(zq[1].y), "+v"(zq[2].x), "+v"(zq[2].y), "+v"(zq[3].x), "+v"(zq[3].y));
            if (c > 0) {
#pragma unroll
                for (int q = 0; q < 4; ++q) { u32x2 w; w.x = cvt_pk_bf16(hacc[4 * q], hacc[4 * q + 1]); w.y = cvt_pk_bf16(hacc[4 * q + 2], hacc[4 * q + 3]);
                    *(LAS u32x2*)(L + SD_HB + (pt * 32 + r32) * SD_RS + (nt * 32 + 8 * q + 4 * hi) * 2) = w; }
            }
#pragma unroll
            for (int i = 0; i < 5; ++i) {
                if ((i == 0 && wave == 0) || (i == 2 && wave == 3) || (i == 4 && wave == 5)) {
                    const int chl = i < 2 ? 64 + 2 * lane : (i < 4 ? 192 + 2 * lane : 2 * (lane & 31));
                    const LAS float* WL = (const LAS float*)(L + SD_WL) + chl;
                    typedef float f32x2w __attribute__((ext_vector_type(2)));
                    const f32x2w wq0 = *(const LAS f32x2w*)(WL), wq1 = *(const LAS f32x2w*)(WL + 320), wq2 = *(const LAS f32x2w*)(WL + 640), wq3 = *(const LAS f32x2w*)(WL + 960), bq = *(const LAS f32x2w*)(WL + 1280);
                    const bool mine = (i < 4) || (lane < 32);
#pragma unroll
                    for (int e = 0; e < 3; ++e) {
                        const float x0 = fmaf(wq3.x, bflo(HR[e + 3]), fmaf(wq2.x, bflo(HR[e + 2]), fmaf(wq1.x, bflo(HR[e + 1]), fmaf(wq0.x, bflo(HR[e]), bq.x))));
                        const float x1 = fmaf(wq3.y, bfhi(HR[e + 3]), fmaf(wq2.y, bfhi(HR[e + 2]), fmaf(wq1.y, bfhi(HR[e + 1]), fmaf(wq0.y, bfhi(HR[e]), bq.y))));
                        const unsigned pk = cvt_pk_bf16(siluf_(x0), siluf_(x1));
                        R[i][e] = mine ? pk : R[i][e];
                    }
                }
                const int s0 = 8 * TG(i);
                if (i < 2) {
#pragma unroll
                    for (int e = 0; e < 8; ++e) *(LAS unsigned*)(L + SD_BM + (s0 + e) * SD_RS + 4 * lane) = R[i][e];
                    typedef float f32x2p __attribute__((ext_vector_type(2)));
                    const f32x4 wa = *(const LAS f32x4*)(SC + 256 + s0), wb = *(const LAS f32x4*)(SC + 256 + s0 + 4);
                    f32x2p pv[8];
#pragma unroll
                    for (int e = 0; e < 8; ++e) { const f32x2p u = {bflo(R[i][e]), bfhi(R[i][e])}; pv[e] = u * (e < 4 ? wa[e] : wb[e - 4]); }
                    *(LAS bf16x8v*)(L + SD_BW + (2 * lane) * SD_RS + s0 * 2) = pack8(pv[0].x, pv[1].x, pv[2].x, pv[3].x, pv[4].x, pv[5].x, pv[6].x, pv[7].x);
                    *(LAS bf16x8v*)(L + SD_BW + (2 * lane + 1) * SD_RS + s0 * 2) = pack8(pv[0].y, pv[1].y, pv[2].y, pv[3].y, pv[4].y, pv[5].y, pv[6].y, pv[7].y);
                } else if (i < 4) {
#pragma unroll
                    for (int e = 0; e < 8; ++e) *(LAS unsigned*)(L + SD_CM + (s0 + e) * SD_RS + 4 * lane) = R[i][e];
                } else {
                    const int p0 = 2 * (lane & 31);
                    u32x4 lo, hi_;
                    lo.x = __builtin_amdgcn_perm(R[4][1], R[4][0], 0x05040100u); lo.y = __builtin_amdgcn_perm(R[4][3], R[4][2], 0x05040100u); lo.z = __builtin_amdgcn_perm(R[4][5], R[4][4], 0x05040100u); lo.w = __builtin_amdgcn_perm(R[4][7], R[4][6], 0x05040100u);
                    hi_.x = __builtin_amdgcn_perm(R[4][1], R[4][0], 0x07060302u); hi_.y = __builtin_amdgcn_perm(R[4][3], R[4][2], 0x07060302u); hi_.z = __builtin_amdgcn_perm(R[4][5], R[4][4], 0x07060302u); hi_.w = __builtin_amdgcn_perm(R[4][7], R[4][6], 0x07060302u);
                    *(LAS u32x4*)(L + SD_XT + p0 * SD_RS + s0 * 2) = lo;
                    *(LAS u32x4*)(L + SD_XT + (p0 + 1) * SD_RS + s0 * 2) = hi_;
                }
            }
            if (c < 15) { SSD_ISSUE_LOADS(c + 1, 0, 2); SSD_ISSUE_HR(c + 1); SSD_ISSUE_Z(c + 1); if (DECF) DECS_LOAD(c + 1); }
            const int ltok = lt * 32 + r32; const size_t yrow = (size_t)(b * SEQ + c * 128 + ltok);
            __syncthreads();
            P_END(51, L, wave); P_BEGIN(52, L, wave);
            f32x16 cbt[2]; int tl[2], ts[2];
#pragma unroll
            for (int k = 0; k < 2; ++k) {
                const int idx = k == 0 ? wave : ((wave == 4 || wave == 5) ? wave + 4 : 99); cbt[k] = (f32x16){};
                { const int j = idx - 4; tl[k] = idx < 4 ? idx : (j < 1 ? 1 : (j < 3 ? 2 : 3)); ts[k] = idx < 4 ? idx : j - (tl[k] == 1 ? 0 : (tl[k] == 2 ? 1 : 3)); }
                if (idx < 10) {
#pragma unroll
                    for (int ks = 0; ks < 8; ++ks) {
                        const bf16x8v af = *(const LAS bf16x8v*)(L + SD_BM + (ts[k] * 32 + r32) * SD_RS + (ks * 16 + hi * 8) * 2);
                        const bf16x8v bf = *(const LAS bf16x8v*)(L + SD_CM + (tl[k] * 32 + r32) * SD_RS + (ks * 16 + hi * 8) * 2);
                        cbt[k] = MFMA32(af, bf, cbt[k]);
                    }
                }
            }
            {
                const float cd = SC[512];
                hacc = hacc * cd;
#pragma unroll
                for (int ks = 0; ks < 8; ++ks) {
                    const bf16x8v af = *(const LAS bf16x8v*)(L + SD_BW + (nt * 32 + r32) * SD_RS + (ks * 16 + hi * 8) * 2);
                    const bf16x8v bf = *(const LAS bf16x8v*)(L + SD_XT + (pt * 32 + r32) * SD_RS + (ks * 16 + hi * 8) * 2);
                    hacc = MFMA32(af, bf, hacc);
                }
            }
            __syncthreads();
            P_END(52, L, wave); P_BEGIN(53, L, wave);
            if (wave == 7 && c < 15) { SSD_SCAN((LAS float*)(L + SD_SC + ((c + 1) & 1) * SD_SCB)); if (c < 14) SSD_ISSUE_DT(c + 2); }
#pragma unroll
            for (int k = 0; k < 2; ++k) {
                if (k == 0 || wave == 4 || wave == 5) {
                    const int l = tl[k] * 32 + r32;
                    if (ts[k] < tl[k]) {
                        const float rf = SC[516 + l];
#pragma unroll
                        for (int q = 0; q < 4; ++q) {
                            const int sb = ts[k] * 32 + 8 * q + 4 * hi;
                            const f32x4 cf = *(const LAS f32x4*)(SC + 644 + (tl[k] - 1) * 128 + sb) * rf;
                            u32x2 w; w.x = cvt_pk_bf16(cbt[k][4 * q] * cf[0], cbt[k][4 * q + 1] * cf[1]); w.y = cvt_pk_bf16(cbt[k][4 * q + 2] * cf[2], cbt[k][4 * q + 3] * cf[3]);
                            *(LAS u32x2*)(L + SD_BM + l * SD_RS + sb * 2) = w;
                        }
                    } else {
                        const float cl_ = SC[l];
#pragma unroll
                        for (int q = 0; q < 4; ++q) {
                            const int sb = ts[k] * 32 + 8 * q + 4 * hi;
                            const f32x4 cs = *(const LAS f32x4*)(SC + sb), ds = *(const LAS f32x4*)(SC + 128 + sb);
                            f32x4 tq = (cl_ - cs);
#pragma unroll
                            for (int e = 0; e < 4; ++e) tq[e] = fminf(tq[e], 0.f);
                            tq = tq * 1.4426950408889634f;
#pragma unroll
                            for (int e = 0; e < 4; ++e) tq[e] = __builtin_amdgcn_exp2f(tq[e]);
                            const f32x4 cq = {cbt[k][4 * q], cbt[k][4 * q + 1], cbt[k][4 * q + 2], cbt[k][4 * q + 3]};
                            tq = (tq * ds) * cq;
                            float wv[4];
#pragma unroll
                            for (int e = 0; e < 4; ++e) wv[e] = (sb + e <= l) ? tq[e] : 0.f;
                            u32x2 w; w.x = cvt_pk_bf16(wv[0], wv[1]); w.y = cvt_pk_bf16(wv[2], wv[3]);
                            *(LAS u32x2*)(L + SD_BM + l * SD_RS + sb * 2) = w;
                        }
                    }
                }
            }
            __syncthreads();
            P_END(53, L, wave); P_BEGIN(54, L, wave);
            if (c < 15) { SSD_ISSUE_LOADS(c + 1, 2, 5); }
            if (c < 15) SSD_SCAN2((LAS float*)(L + SD_SC + ((c + 1) & 1) * SD_SCB));
            f32x16 ya = {};
            if (c > 0) {
#pragma unroll
                for (int ks = 0; ks < 8; ++ks) {
                    const bf16x8v af = *(const LAS bf16x8v*)(L + SD_HB + (pt * 32 + r32) * SD_RS + (ks * 16 + hi * 8) * 2);
                    const bf16x8v bf = *(const LAS bf16x8v*)(L + SD_CM + (lt * 32 + r32) * SD_RS + (ks * 16 + hi * 8) * 2);
                    ya = MFMA32(af, bf, ya);
                }
                ya = ya * SC[384 + ltok];
            }
#pragma unroll
            for (int st = 0; st < 4; ++st) {
                if (st <= lt) {
#pragma unroll
                    for (int k2 = 0; k2 < 2; ++k2) {
                        const int kk = st * 32 + k2 * 16 + hi * 8;
                        const bf16x8v af = *(const LAS bf16x8v*)(L + SD_XT + (pt * 32 + r32) * SD_RS + kk * 2);
                        const bf16x8v bf = *(const LAS bf16x8v*)(L + SD_BM + (lt * 32 + r32) * SD_RS + kk * 2);
                        ya = MFMA32(af, bf, ya);
                    }
                }
            }
            {
                float ssq = 0.f; u32x2 yw[4];
#pragma unroll
                for (int q = 0; q < 4; ++q) {
                    const int p0 = pt * 32 + 8 * q + 4 * hi;
                    f32x4 xv4;
#pragma unroll
                    for (int e = 0; e < 4; ++e) xv4[e] = bf2f(*(const LAS unsigned short*)(L + SD_XT + (p0 + e) * SD_RS + ltok * 2));
                    const f32x4 ya4 = {ya[4 * q], ya[4 * q + 1], ya[4 * q + 2], ya[4 * q + 3]}, z4 = {bflo(zq[q].x), bfhi(zq[q].x), bflo(zq[q].y), bfhi(zq[q].y)};
                    const f32x4 y = (ya4 + xv4 * Dk) * z4, y2 = y * y;
                    ssq += (y2[0] + y2[1]) + (y2[2] + y2[3]);
                    yw[q].x = cvt_pk_bf16(y[0], y[1]); yw[q].y = cvt_pk_bf16(y[2], y[3]);
                }
                {
                    const auto s0 = __builtin_amdgcn_permlane32_swap(yw[0].x, yw[2].x, false, false), s1 = __builtin_amdgcn_permlane32_swap(yw[0].y, yw[2].y, false, false);
                    const auto s2 = __builtin_amdgcn_permlane32_swap(yw[1].x, yw[3].x, false, false), s3 = __builtin_amdgcn_permlane32_swap(yw[1].y, yw[3].y, false, false);
                    bf16* yp = YZ + yrow * 3072 + hh * 64 + pt * 32 + 16 * hi;
                    *(u32x4*)yp = (u32x4){s0[0], s1[0], s0[1], s1[1]}; *(u32x4*)(yp + 8) = (u32x4){s2[0], s3[0], s2[1], s3[1]};
                }
                ssq += __shfl_xor(ssq, 32);
                if (hi == 0) SSQ2[yrow * 64 + hh * 2 + pt] = ssq;
            }
            P_END(54, L, wave);
        }
        {
            float* hp = a.out + O_HP + ((size_t)(b * SH + hh) * 64 + pt * 32 + r32) * 128 + nt * 32 + 4 * hi;
#pragma unroll
            for (int q = 0; q < 4; ++q) *(f32x4*)(hp + 8 * q) = (f32x4){hacc[4 * q], hacc[4 * q + 1], hacc[4 * q + 2], hacc[4 * q + 3]};
        }
        __syncthreads();
    }
}


template <int KW, bool SSQ>
__device__ __forceinline__ void mini_acc(f32x16& acc, float& ssq, const bf16* wrow, const bf16* xrow) {
    constexpr int NS = KW / 16, BT = NS < 16 ? NS : 16;
#pragma unroll
    for (int s0 = 0; s0 < NS; s0 += BT) {
        bf16x8v wa[BT], xa[BT];
#pragma unroll
        for (int s = 0; s < BT; ++s) { wa[s] = *(const bf16x8v*)(wrow + 8 * (s0 + s)); xa[s] = *(const bf16x8v*)(xrow + 8 * (s0 + s)); }
#pragma unroll
        for (int s = 0; s < BT; ++s) {
            acc = MFMA32(wa[s], xa[s], acc);
            if (SSQ) {
                const u32x4 xw = __builtin_bit_cast(u32x4, xa[s]);
                ssq += bflo(xw.x) * bflo(xw.x) + bfhi(xw.x) * bfhi(xw.x) + bflo(xw.y) * bflo(xw.y) + bfhi(xw.y) * bfhi(xw.y) + bflo(xw.z) * bflo(xw.z) + bfhi(xw.z) * bfhi(xw.z) + bflo(xw.w) * bflo(xw.w) + bfhi(xw.w) * bfhi(xw.w);
            }
        }
    }
}
__device__ __forceinline__ void mini_reduce(LAS float* red, const f32x16& acc, int wave, int lane, float& o0, float& o1) {
#pragma unroll
    for (int r = 0; r < 16; ++r) red[(wave * 16 + r) * 64 + lane] = acc[r];
    __syncthreads();
    float a0 = 0.f, a1 = 0.f;
#pragma unroll
    for (int p = 0; p < 8; ++p) { a0 += red[(p * 16 + 2 * wave) * 64 + lane]; a1 += red[(p * 16 + 2 * wave + 1) * 64 + lane]; }
    o0 = a0; o1 = a1;
}
__device__ __forceinline__ float mini_reduce_ssq(LAS float* reds, float ssq, int wave, int lane) {
    reds[wave * 64 + lane] = ssq;
    __syncthreads();
    float s = 0.f;
#pragma unroll
    for (int p = 0; p < 8; ++p) s += reds[p * 64 + (lane & 31)] + reds[p * 64 + (lane & 31) + 32];
    return s;
}
template <int WHICH>
__device__ __forceinline__ void mini_gemm(Frame& F, const Args& a) {
    unsigned char* ws = a.ws;
    int tid_ = F.wave * 64 + (int)__builtin_amdgcn_mbcnt_hi(~0u, __builtin_amdgcn_mbcnt_lo(~0u, 0u)); asm volatile("" : "+v"(tid_));
    const int lane = tid_ & 63, wave = __builtin_amdgcn_readfirstlane(tid_ >> 6), r32 = lane & 31, hi = lane >> 5;
    LAS float* red = (LAS float*)F.lds; LAS float* red2 = red + 8 * 16 * 64; LAS float* reds = red2 + 8 * 16 * 64;
    const bf16* OA = (const bf16*)(ws + WS_OA); const bf16* YZ = (const bf16*)(ws + WS_OA) + 1024; const bf16* GT = (const bf16*)(ws + WS_GT);
    bf16* MIX = (bf16*)(ws + WS_XB); bf16* X1B = (bf16*)(ws + WS_OA); bf16* ACT = (bf16*)(ws + WS_ZS);
    constexpr int NT = (WHICH == 5 ? 4096 : 1024) / 32;
    for (int t = F.vcu; t < 4 * NT; t += F.G) {
        const int tt = t & 3, n0 = (t >> 2) * 32, tok = tt * 32 + r32, row = MP + tok;
        const int nl = 2 * (wave & 1) + 8 * (wave >> 1) + 4 * hi, n = n0 + nl;
        __syncthreads();
        if (WHICH == 3) {
            f32x16 acc1 = {}, acc2 = {}; float ssq = 0.f, d = 0.f;
            mini_acc<128, false>(acc1, d, (const bf16*)(ws + WS_WTA) + (size_t)(n0 + r32) * 3072 + wave * 128 + hi * 64, OA + (size_t)row * 3072 + wave * 128 + hi * 64);
            mini_acc<256, true>(acc2, ssq, (const bf16*)(ws + WS_WTA) + 1024 + (size_t)(n0 + r32) * 3072 + wave * 256 + hi * 128, YZ + (size_t)row * 3072 + wave * 256 + hi * 128);
            float p0, p1, q0, q1;
            mini_reduce(red, acc1, wave, lane, p0, p1); mini_reduce(red2, acc2, wave, lane, q0, q1);
            const float r2 = frsq_(mini_reduce_ssq(reds, ssq, wave, lane) * (1.0f / 2048.0f) + EPS);
            const unsigned ga = *(const unsigned*)(GT + (size_t)row * 2048 + n), gs = *(const unsigned*)(GT + (size_t)row * 2048 + 1024 + n);
            *(unsigned*)(MIX + (size_t)row * 1024 + n) = cvt_pk_bf16(bflo(ga) * p0 + bflo(gs) * r2 * q0, bfhi(ga) * p1 + bfhi(gs) * r2 * q1);
        } else if (WHICH == 4) {
            f32x16 acc = {}; float d = 0.f;
            mini_acc<128, false>(acc, d, (const bf16*)(ws + WS_WTO) + (size_t)(n0 + r32) * 1024 + wave * 128 + hi * 64, MIX + (size_t)row * 1024 + wave * 128 + hi * 64);
            float p0, p1; mini_reduce(red, acc, wave, lane, p0, p1);
            const float* xr = a.in[I_XS] + (size_t)tok * 1024 + n;
            const float v0 = xr[0] + p0, v1 = xr[1] + p1;
            *(unsigned*)(X1B + (size_t)row * 1024 + n) = cvt_pk_bf16(v0, v1);
        } else if (WHICH == 5) {
            f32x16 acc = {}; float ssq = 0.f;
            mini_acc<128, true>(acc, ssq, (const bf16*)(ws + WS_WTU) + (size_t)(n0 + r32) * 1024 + wave * 128 + hi * 64, X1B + (size_t)row * 1024 + wave * 128 + hi * 64);
            float p0, p1; mini_reduce(red, acc, wave, lane, p0, p1);
            const float r3 = frsq_(mini_reduce_ssq(reds, ssq, wave, lane) * (1.0f / 1024.0f) + EPS);
            float u0 = fmaxf(p0 * r3, 0.f), u1 = fmaxf(p1 * r3, 0.f);
            *(unsigned*)(ACT + (size_t)row * 4096 + n) = cvt_pk_bf16(u0 * u0, u1 * u1);
        } else {
            f32x16 acc = {}; float d = 0.f;
            mini_acc<512, false>(acc, d, (const bf16*)(ws + WS_WTD) + (size_t)(n0 + r32) * 4096 + wave * 512 + hi * 256, ACT + (size_t)row * 4096 + wave * 512 + hi * 256);
            float p0, p1; mini_reduce(red, acc, wave, lane, p0, p1);
            const unsigned xw = *(const unsigned*)(X1B + (size_t)row * 1024 + n);
            float* o = a.out + (size_t)row * 1024 + n; o[0] = bflo(xw) + p0; o[1] = bfhi(xw) + p1;
        }
    }
    __syncthreads();
}


__device__ __forceinline__ void ssd_decode_fast(Frame& F, const Args& a) {
    unsigned char* ws = a.ws;
    const bf16* ZS = (const bf16*)(ws + WS_ZS); const float* DT = (const float*)(ws + WS_DT); bf16* YZ = (bf16*)(ws + WS_OA) + 1024;
    const float* cw = a.in[I_CW]; const float* cb = a.in[I_CB]; const float* sc = a.in[I_SC]; const float* h0 = a.in[I_SS];
    LAS float* xc = (LAS float*)(F.lds);
    LAS float* dtv = xc + 768;
    int tid_ = F.wave * 64 + (int)__builtin_amdgcn_mbcnt_hi(~0u, __builtin_amdgcn_mbcnt_lo(~0u, 0u)); asm volatile("" : "+v"(tid_));
    const int tid = tid_, p = tid >> 3, nq = tid & 7;
    for (int item = F.vcu; item < DEC * SG; item += F.G) {
        const int b = item >> 2, g = item & 3, r = MP + b;
        __syncthreads();
        f32x4 hs[8][4];
#pragma unroll
        for (int j = 0; j < 8; ++j) { const float* hin = h0 + ((size_t)(b * SH + 8 * g + j) * 64 + p) * 128 + nq * 16;
#pragma unroll
            for (int i = 0; i < 4; ++i) hs[j][i] = *(const f32x4*)(hin + 4 * i); }
        float zsv[8];
#pragma unroll
        for (int j = 0; j < 8; ++j) zsv[j] = bf2f(ZS[(size_t)r * 2048 + (8 * g + j) * 64 + p]);
#pragma unroll
        for (int q = 0; q < 2; ++q) {
            const int e = tid + 512 * q;
            if (e < 768) {
                const int gch = e < 512 ? 512 * g + e : (e < 640 ? 2048 + 128 * g + (e - 512) : 2560 + 128 * g + (e - 640));
                float acc = cb[gch] + cw[gch] * sc[((size_t)b * 3) * 3072 + gch] + cw[3072 + gch] * sc[((size_t)b * 3 + 1) * 3072 + gch] + cw[2 * 3072 + gch] * sc[((size_t)b * 3 + 2) * 3072 + gch]
                          + cw[3 * 3072 + gch] * a.out[O_CS + ((size_t)b * 3 + 2) * 3072 + gch];
                xc[e] = siluf_(acc);
            }
        }
        if (tid < 8) dtv[tid] = DT[(size_t)r * 32 + 8 * g + tid];
        __syncthreads();
        float Bv[16], Cv[16];
#pragma unroll
        for (int i = 0; i < 4; ++i) { const f32x4 bb = *(const LAS f32x4*)(xc + 512 + nq * 16 + 4 * i), cc = *(const LAS f32x4*)(xc + 640 + nq * 16 + 4 * i);
            Bv[4 * i] = bb[0]; Bv[4 * i + 1] = bb[1]; Bv[4 * i + 2] = bb[2]; Bv[4 * i + 3] = bb[3]; Cv[4 * i] = cc[0]; Cv[4 * i + 1] = cc[1]; Cv[4 * i + 2] = cc[2]; Cv[4 * i + 3] = cc[3]; }
#pragma unroll
        for (int j = 0; j < 8; ++j) {
            const int hh = 8 * g + j;
            const float dt = dtv[j], dA = __expf(-dt * __expf(a.in[I_ALOG][hh])), x = xc[64 * j + p], dx = dt * x;
            float* hout = a.out + O_HS + ((size_t)(b * SH + hh) * 64 + p) * 128 + nq * 16;
            float y = 0.f;
#pragma unroll
            for (int i = 0; i < 4; ++i) { f32x4 hv = hs[j][i];
#pragma unroll
                for (int e = 0; e < 4; ++e) { hv[e] = dA * hv[e] + dx * Bv[4 * i + e]; y += hv[e] * Cv[4 * i + e]; }
                *(f32x4*)(hout + 4 * i) = hv; }
            y += __shfl_xor(y, 1); y += __shfl_xor(y, 2); y += __shfl_xor(y, 4);
            if (nq == 0) YZ[(size_t)r * 3072 + hh * 64 + p] = (bf16)f2bf((y + a.in[I_DSK][hh] * x) * zsv[j]);
        }
    }
    __syncthreads();
}

#ifndef GFLAG_A
#define GFLAG_A true
#define GFLAG_S true
#endif
#ifndef REP_MASK_UNUSED
#define REP_MASK_UNUSED 0
#endif
__global__ void __launch_bounds__(NWAVES * 64, 2) hybrid_fwd(Args args) {
    extern __shared__ __attribute__((aligned(16))) unsigned char lds[];
    Frame F;
    F.lds = (LAS unsigned char*)lds;
    volatile LAS unsigned* MISC = (volatile LAS unsigned*)(F.lds + MISC_OFF);
    F.wave = __builtin_amdgcn_readfirstlane(threadIdx.x >> 6);
    F.G = gridDim.x; { const int bx = blockIdx.x; F.vcu = (F.G % 8 == 0) ? (bx % 8) * (F.G / 8) + bx / 8 : bx; }
    unsigned char* ws = args.ws;
    gu32* ctl = (gu32*)(ws + WS_CTL);
    for (int u = threadIdx.x; u < (LDS_BYTES - LDSCTL_OFF) / 4; u += NWAVES * 64) ((LAS unsigned*)(F.lds + LDSCTL_OFF))[u] = 0u;
    __syncthreads();
    XcdBarrier bar = xcd_barrier_post((unsigned*)(ctl + CW_BAR), MISC + 8);
    P_BEGIN(60, F.lds, F.wave);
    const int lo = args.ph_lo, hi = args.ph_hi;
#ifndef PHASE_MASK
#define PHASE_MASK 0x7f
#endif
#define IN(k) ((((PHASE_MASK) >> (k)) & 1) && lo <= (k) && (k) < hi)
#define BOTH(k) (IN(k) && IN((k) + 1))
#define GRID_BAR() do { xcd_barrier(bar); if ((REP_MASK) & 0x400) xcd_barrier(bar); } while (0)

    bf16* WT1 = (bf16*)(ws + WS_WT1); bf16* WTA = (bf16*)(ws + WS_WTA); bf16* WTS = (bf16*)(ws + WS_WTS); bf16* WTO = (bf16*)(ws + WS_WTO); bf16* WTU = (bf16*)(ws + WS_WTU); bf16* WTD = (bf16*)(ws + WS_WTD);
    bf16* XB = (bf16*)(ws + WS_XB); bf16* Qb = (bf16*)(ws + WS_Q); bf16* Kb = (bf16*)(ws + WS_K); bf16* Vb = (bf16*)(ws + WS_V); bf16* OA = (bf16*)(ws + WS_OA);
    bf16* YZ = (bf16*)(ws + WS_YZ); bf16* GT = (bf16*)(ws + WS_GT); bf16* ZS = (bf16*)(ws + WS_ZS); bf16* XBC = (bf16*)(ws + WS_XBC);
    float* DT = (float*)(ws + WS_DT); float* SSQ2 = (float*)(ws + WS_SSQ2); float* SSQ3 = (float*)(ws + WS_SSQ3); float* ROPE = (float*)(ws + WS_ROPE);
    float* T1 = (float*)(ws + WS_ZS); bf16* MIX = XB; bf16* X1B = OA; bf16* ACT = ZS;

    P_BEGIN(1, F.lds, F.wave); if (IN(0)) { _Pragma("unroll 1") for (int rep = 0; rep < REPS(0); ++rep) p0_prologue(F, args); if (BOTH(0)) GRID_BAR(); } P_END(1, F.lds, F.wave);
    P_BEGIN(2, F.lds, F.wave);
    if (IN(1)) {
        pg8::Gemm g{XB, WT1, MPAD, N1, 1024}; pg8::StaticOrder S; S.init(MPAD, N1, F.G, (int)blockIdx.x);
        EpiIn E{ws, args.out, args.in[I_QN], args.in[I_KN], args.in[I_DTB], args.in[I_CW], args.in[I_CB]};
        _Pragma("unroll 1") for (int rep = 0; rep < REPS(1); ++rep) pg8::gemm_phase<EpiIn, pg8::StaticOrder, GFLAG_A, GFLAG_S, true>(F.lds + RING_OFF, g, S, E, F.wave);
        if (BOTH(1)) GRID_BAR();
    }
    P_END(2, F.lds, F.wave); P_BEGIN(3, F.lds, F.wave);
    if (IN(2)) {
#ifndef P2_MASK
#define P2_MASK 7
#endif
        const bool dec_first = ((blockIdx.x >> 3) & 1) == 0;
        if (F.G == NB * SH) {
            if (dec_first) { P_BEGIN(22, F.lds, F.wave); attn_simple<true>(F, args); P_END(22, F.lds, F.wave); }
            { _Pragma("unroll 1") for (int rep = 0; rep < REPS(3); ++rep) { P_BEGIN(20, F.lds, F.wave); attn_prompt_mfma(F, args); P_END(20, F.lds, F.wave); } }
            { P_BEGIN(23, F.lds, F.wave); decode_conv_to_lds(F, args); ssd_prompt_mfma<true>(F, args); P_END(23, F.lds, F.wave); }
            if (!dec_first) { P_BEGIN(22, F.lds, F.wave); attn_simple<true>(F, args); P_END(22, F.lds, F.wave); }
        }
        if (BOTH(2)) GRID_BAR();
    }
    P_END(3, F.lds, F.wave); P_BEGIN(4, F.lds, F.wave);
    if (IN(3)) {
        { pg8::Gemm g{OA, WTA, MP, 1024, 3072}; pg8::StaticOrder S; S.init(MP, 1024, F.G, (int)blockIdx.x);
          { pg8::Unit u0; LAS float* R2L = (LAS float*)(F.lds + R2_OFF);
            if (S.next(0, u0)) { int tid_ = F.wave * 64 + (int)__builtin_amdgcn_mbcnt_hi(~0u, __builtin_amdgcn_mbcnt_lo(~0u, 0u)); asm volatile("" : "+v"(tid_));
                const f32x4* p = (const f32x4*)(SSQ2 + (size_t)(u0.pm * 256 + (tid_ >> 1)) * 64 + 32 * (tid_ & 1));
                f32x4 q[8];
#pragma unroll
                for (int j = 0; j < 8; ++j) q[j] = p[j];
                float ss = 0.f;
#pragma unroll
                for (int j = 0; j < 8; ++j) ss += (q[j][0] + q[j][1]) + (q[j][2] + q[j][3]);
                ss += __builtin_bit_cast(float, __builtin_amdgcn_update_dpp(0, __builtin_bit_cast(int, ss), 0xB1, 0xf, 0xf, true));
                const float r2 = frsq_(ss * (1.0f / 2048.0f) + EPS);
                if ((tid_ & 1) == 0) { R2L[tid_ >> 1] = r2; R2L[256 + (tid_ >> 1)] = frcp_(r2); } }
            __syncthreads(); }
          EpiMixF E{GT, MIX, (const LAS float*)(F.lds + R2_OFF)};
          _Pragma("unroll 1") for (int rep = 0; rep < REPS(5); ++rep) pg8::gemm_phase<EpiMixF, pg8::StaticOrder, true, true>(F.lds + RING_OFF, g, S, E, F.wave); }
        _Pragma("unroll 1") for (int rep = 0; rep < REPS(8); ++rep) mini_gemm<3>(F, args);
        if (BOTH(3)) GRID_BAR();
    }
    P_END(4, F.lds, F.wave); P_BEGIN(5, F.lds, F.wave);
    if (IN(4)) {
        pg8::Gemm g{MIX, WTO, MP, 1024, 1024}; pg8::StaticOrder S; S.init(MP, 1024, F.G, (int)blockIdx.x);
        EpiRes1 E{args.in[I_XP], args.in[I_XS], args.out, X1B, SSQ3};
        _Pragma("unroll 1") for (int rep = 0; rep < REPS(6); ++rep) pg8::gemm_phase<EpiRes1, pg8::StaticOrder, true, true>(F.lds + RING_OFF, g, S, E, F.wave);
        _Pragma("unroll 1") for (int rep = 0; rep < REPS(8); ++rep) mini_gemm<4>(F, args);
        if (BOTH(4)) GRID_BAR();
    }
    P_END(5, F.lds, F.wave); P_BEGIN(6, F.lds, F.wave);
    if (IN(5)) {
        pg8::Gemm g{X1B, WTU, MP, 4096, 1024}; pg8::StaticOrder S; S.init(MP, 4096, F.G, (int)blockIdx.x);
        EpiUp E{SSQ3, ACT};
        _Pragma("unroll 1") for (int rep = 0; rep < REPS(7); ++rep) pg8::gemm_phase<EpiUp, pg8::StaticOrder, GFLAG_A, GFLAG_S>(F.lds + RING_OFF, g, S, E, F.wave);
        _Pragma("unroll 1") for (int rep = 0; rep < REPS(8); ++rep) mini_gemm<5>(F, args);
        if (BOTH(5)) GRID_BAR();
    }
    P_END(6, F.lds, F.wave); P_BEGIN(7, F.lds, F.wave);
    if (IN(6)) {
        pg8::Gemm g{ACT, WTD, MP, 1024, 4096}; pg8::StaticOrder S; S.init(MP, 1024, F.G, (int)blockIdx.x);
        EpiDown E{X1B, args.out};
        pg8::gemm_phase<EpiDown, pg8::StaticOrder, true, true>(F.lds + RING_OFF, g, S, E, F.wave);
        mini_gemm<6>(F, args);
    }
    P_END(7, F.lds, F.wave);
    P_END(60, F.lds, F.wave);
#ifndef PROBE_MAX
#define PROBE_MAX 0
#endif
    if (PROBE_ID != 0 && PROBE_MAX) {
        if (F.wave == 0) atomicMax((unsigned*)(ws + WS_CTL + 8192), __float_as_uint(*(LAS float*)(F.lds + MISC_OFF + 72)));
        xcd_barrier(bar);
        if (blockIdx.x == 0 && F.wave == 0) args.out[O_KS] = 0.01f * __uint_as_float(*(volatile unsigned*)(ws + WS_CTL + 8192));
    } else
    if (PROBE_ID == 60 && blockIdx.x == 0 && F.wave == 0) args.out[0] = 0.001f * *(LAS float*)(F.lds + MISC_OFF + 72);
    else if (PROBE_ID != 0 && blockIdx.x == 0 && F.wave == 0) args.out[O_KS] = 0.01f * *(LAS float*)(F.lds + MISC_OFF + 72);
#undef IN
#undef BOTH
#undef GRID_BAR
}

#ifndef MK_N_LAUNCHES
#define MK_N_LAUNCHES 1
#endif
extern "C" void kernel_launch(void* const* d_in, const int* in_sizes, int n_in, void* d_out, int out_size, void* d_ws, size_t ws_size, hipStream_t stream) {
    static int grid = 0;
    if (grid == 0) {
        if (n_in != 23 || ws_size < WS_END || out_size != 62726144) { fprintf(stderr, "kernel_launch: unexpected n_in %d / ws %zu / out %d; nothing launched\n", n_in, ws_size, out_size); grid = -1; return; }
        int dev = 0, cus = 0, per_cu = 0;
        if (hipGetDevice(&dev) != hipSuccess || hipDeviceGetAttribute(&cus, hipDeviceAttributeMultiprocessorCount, dev) != hipSuccess) { grid = -1; return; }
        if (hipFuncSetAttribute((const void*)hybrid_fwd, hipFuncAttributeMaxDynamicSharedMemorySize, LDS_BYTES) != hipSuccess) { fprintf(stderr, "kernel_launch: hipFuncSetAttribute failed\n"); grid = -1; return; }
        if (hipOccupancyMaxActiveBlocksPerMultiprocessor(&per_cu, (const void*)hybrid_fwd, NWAVES * 64, LDS_BYTES) != hipSuccess || per_cu < 1) { fprintf(stderr, "kernel_launch: occupancy query reports %d blocks per CU\n", per_cu); per_cu = 1; }
        (void)hipGetLastError();
        grid = cus >= 256 ? 256 : cus;
    }
    if (grid < 0) return;
    if (hipMemsetAsync((char*)d_ws + WS_CTL, 0, CTL_ZERO_BYTES, stream) != hipSuccess) { fprintf(stderr, "kernel_launch: memset failed\n"); return; }
    Args a{};
    for (int i = 0; i < 23; ++i) a.in[i] = (const float*)d_in[i];
    a.out = (float*)d_out; a.ws = (unsigned char*)d_ws;
    for (int i = 0; i < 32; ++i) a.invf[i] = pow(10000.0, -(double)i / 32.0);
#if MK_N_LAUNCHES == 1
    a.ph_lo = 0; a.ph_hi = 7;
    void* kargs[] = {&a};
    hipError_t e = hipLaunchCooperativeKernel((const void*)hybrid_fwd, dim3(grid), dim3(NWAVES * 64), kargs, LDS_BYTES, stream);
    if (e != hipSuccess) fprintf(stderr, "kernel_launch: cooperative launch failed: %s (grid %d)\n", hipGetErrorString(e), grid);
#else
    for (int li = 0; li < 7; ++li) { a.ph_lo = li; a.ph_hi = li + 1; hipLaunchKernelGGL(hybrid_fwd, dim3(grid), dim3(NWAVES * 64), LDS_BYTES, stream, a); }
#endif
}
```
